# Optimizing an MI355X kernel written in HIP

```python
import math
import jax, jax.numpy as jnp
from jax import lax
import numpy as np

D_MODEL = 2048
BATCH = 4
SEQ = 4096
DEPTH = 4

GMLP_WIDTH = D_MODEL // 2
GMLP_GROUPS = 8
GMLP_GROUP_DIM = GMLP_WIDTH // GMLP_GROUPS
CHUNK = 128

ATTN_HEADS = 8
ATTN_WIDTH = D_MODEL // 2
ATTN_V_DIM = ATTN_WIDTH // ATTN_HEADS
ATTN_QK_DIM = ATTN_V_DIM // 2
Q_BLOCK = 128
ROPE_THETA = 10000.0

N_BRANCH = 2
QK_WIDTH = ATTN_HEADS * 2 * ATTN_QK_DIM
SPLITS = (GMLP_WIDTH, 2 * GMLP_WIDTH, 2 * GMLP_WIDTH + QK_WIDTH, 2 * GMLP_WIDTH + 2 * QK_WIDTH,
          2 * GMLP_WIDTH + 2 * QK_WIDTH + ATTN_WIDTH)
D_IN = 2 * GMLP_WIDTH + 2 * QK_WIDTH + ATTN_WIDTH + N_BRANCH * D_MODEL

FFN_HIDDEN = -(-8 * D_MODEL // (3 * 256)) * 256
EPS = 1e-6

kernel_name = "hybrid_gmlp_diffattn_adaln_encoder"


def rms_norm(x, g):
    xf = x.astype(jnp.float32)
    y = xf * lax.rsqrt(jnp.mean(xf * xf, axis=-1, keepdims=True) + EPS)
    return (y * g.astype(jnp.float32)).astype(x.dtype)


def layer_norm(x, g, b):
    xf = x.astype(jnp.float32)
    mu = jnp.mean(xf, axis=-1, keepdims=True)
    var = jnp.mean(jnp.square(xf - mu), axis=-1, keepdims=True)
    y = (xf - mu) * lax.rsqrt(var + EPS)
    return (y * g.astype(jnp.float32) + b.astype(jnp.float32)).astype(x.dtype)


def rope_tables(seq_len, dim):
    pos = jnp.arange(seq_len, dtype=jnp.float32)
    inv_freq = ROPE_THETA ** (-jnp.arange(0, dim, 2, dtype=jnp.float32) / dim)
    ang = pos[:, None] * inv_freq[None, :]
    return jnp.cos(ang), jnp.sin(ang)


def apply_rope(x, cos, sin):
    cos = cos.astype(x.dtype)
    sin = sin.astype(x.dtype)
    x1, x2 = jnp.split(x, 2, axis=-1)
    return jnp.concatenate([x1 * cos - x2 * sin, x2 * cos + x1 * sin], axis=-1)


def gmlp_spatial_gate(u, v, ln_g, ln_b, w_s, b_s):
    bsz, seq = v.shape[0], v.shape[1]
    v = layer_norm(v, ln_g, ln_b)
    vr = v.reshape(bsz, seq // CHUNK, CHUNK, GMLP_GROUPS, GMLP_GROUP_DIM)
    mixed = jnp.einsum('gpq,bnqgd->bnpgd', w_s, vr) + b_s.T[None, None, :, :, None]
    return u * mixed.reshape(bsz, seq, GMLP_WIDTH)


def differential_attention(q, k, v, lam, sub_g, lambda_init):
    bsz, seq = q.shape[0], q.shape[1]
    cos, sin = rope_tables(seq, ATTN_QK_DIM)
    q = apply_rope(q.transpose(0, 2, 3, 1, 4), cos, sin)
    k = apply_rope(k.transpose(0, 2, 3, 1, 4), cos, sin)
    v = v.transpose(0, 2, 1, 3)
    scale = ATTN_QK_DIM ** -0.5
    n_blk = seq // Q_BLOCK
    qb = q.reshape(bsz, ATTN_HEADS, 2, n_blk, Q_BLOCK, ATTN_QK_DIM).transpose(3, 0, 1, 2, 4, 5)

    def block(q_blk):
        s = jnp.einsum('bhmqd,bhmkd->bhmqk', q_blk, k).astype(jnp.float32) * scale
        p = jax.nn.softmax(s, axis=-1)
        p_diff = p[:, :, 0] - lam * p[:, :, 1]
        return jnp.einsum('bhqk,bhkd->bhqd', p_diff.astype(v.dtype), v)

    o = lax.map(block, qb)
    o = o.transpose(1, 0, 3, 2, 4).reshape(bsz, seq, ATTN_HEADS, ATTN_V_DIM)
    o = rms_norm(o, sub_g) * (1.0 - lambda_init)
    return o.reshape(bsz, seq, ATTN_WIDTH)


def setup_inputs(seed: int = 0) -> dict:
    key = jax.random.key(seed)
    ks = jax.random.split(key, 23)
    f32 = jnp.float32
    L, D = DEPTH, D_MODEL

    def nrm(k, shape, scale):
        return jax.random.normal(k, shape, f32) * scale

    return {
        "x": nrm(ks[0], (BATCH, SEQ, D), 1.0),
        "c": nrm(ks[1], (BATCH, D), 1.0),
        "ada_w": nrm(ks[2], (L, D, 6 * D), 0.5 * D ** -0.5),
        "ada_b": nrm(ks[3], (L, 6 * D), 0.02),
        "norm1_g": 1.0 + nrm(ks[4], (L, D), 0.1),
        "norm2_g": 1.0 + nrm(ks[5], (L, D), 0.1),
        "w_in": nrm(ks[6], (L, D, D_IN), D ** -0.5),
        "gmlp_ln_g": 1.0 + nrm(ks[7], (L, GMLP_WIDTH), 0.1),
        "gmlp_ln_b": nrm(ks[8], (L, GMLP_WIDTH), 0.02),
        "w_s": nrm(ks[9], (L, GMLP_GROUPS, CHUNK, CHUNK), CHUNK ** -0.5),
        "b_s": 1.0 + nrm(ks[10], (L, GMLP_GROUPS, CHUNK), 0.1),
        "lambda_q1": nrm(ks[11], (L, ATTN_QK_DIM), 0.1),
        "lambda_k1": nrm(ks[12], (L, ATTN_QK_DIM), 0.1),
        "lambda_q2": nrm(ks[13], (L, ATTN_QK_DIM), 0.1),
        "lambda_k2": nrm(ks[14], (L, ATTN_QK_DIM), 0.1),
        "subln_g": 1.0 + nrm(ks[15], (L, ATTN_V_DIM), 0.1),
        "w_up_gmlp": nrm(ks[16], (L, GMLP_WIDTH, D), GMLP_WIDTH ** -0.5),
        "w_up_attn": nrm(ks[17], (L, ATTN_WIDTH, D), ATTN_WIDTH ** -0.5),
        "w_o": nrm(ks[18], (L, D, D), D ** -0.5),
        "ffn_w1": nrm(ks[19], (L, D, FFN_HIDDEN), D ** -0.5),
        "ffn_w3": nrm(ks[20], (L, D, FFN_HIDDEN), D ** -0.5),
        "ffn_w2": nrm(ks[21], (L, FFN_HIDDEN, D), FFN_HIDDEN ** -0.5),
        "final_g": 1.0 + nrm(ks[22], (D,), 0.1),
    }


def reference(x, c, ada_w, ada_b, norm1_g, norm2_g, w_in, gmlp_ln_g, gmlp_ln_b, w_s, b_s,
              lambda_q1, lambda_k1, lambda_q2, lambda_k2, subln_g, w_up_gmlp, w_up_attn, w_o,
              ffn_w1, ffn_w3, ffn_w2, final_g):
    bsz, seq = x.shape[0], x.shape[1]
    c_act = jax.nn.silu(c)
    for l in range(DEPTH):
        mod = jnp.dot(c_act, ada_w[l]) + ada_b[l]
        sh1, sc1, gt1, sh2, sc2, gt2 = [m[:, None, :] for m in jnp.split(mod, 6, axis=-1)]

        h = rms_norm(x, norm1_g[l]) * (1.0 + sc1) + sh1
        proj = jnp.dot(h, w_in[l])
        u, v, q, k, va, gate_logits = jnp.split(proj, SPLITS, axis=-1)

        branch_a = gmlp_spatial_gate(jax.nn.gelu(u), jax.nn.gelu(v),
                                     gmlp_ln_g[l], gmlp_ln_b[l], w_s[l], b_s[l])

        lambda_init = 0.8 - 0.6 * math.exp(-0.3 * l)
        lam = (jnp.exp(jnp.sum(lambda_q1[l].astype(jnp.float32) * lambda_k1[l].astype(jnp.float32)))
               - jnp.exp(jnp.sum(lambda_q2[l].astype(jnp.float32) * lambda_k2[l].astype(jnp.float32)))
               + lambda_init)
        branch_b = differential_attention(
            q.reshape(bsz, seq, ATTN_HEADS, 2, ATTN_QK_DIM),
            k.reshape(bsz, seq, ATTN_HEADS, 2, ATTN_QK_DIM),
            va.reshape(bsz, seq, ATTN_HEADS, ATTN_V_DIM),
            lam, subln_g[l], lambda_init)

        gates = jax.nn.sigmoid(gate_logits).reshape(bsz, seq, N_BRANCH, D_MODEL)
        merged = (gates[:, :, 0] * jnp.dot(branch_a, w_up_gmlp[l])
                  + gates[:, :, 1] * jnp.dot(branch_b, w_up_attn[l]))
        x = x + gt1 * jnp.dot(merged, w_o[l])

        h = rms_norm(x, norm2_g[l]) * (1.0 + sc2) + sh2
        f = jnp.dot(jax.nn.silu(jnp.dot(h, ffn_w1[l])) * jnp.dot(h, ffn_w3[l]), ffn_w2[l])
        x = x + gt2 * f
    return rms_norm(x, final_g)
```

```cpp
#include <hip/hip_runtime.h>
#include <hip/hip_bf16.h>
#include <cstdio>
#include <cstdint>
#include <cmath>
namespace pg8 {
#define PG8_LAS __attribute__((address_space(3)))
typedef unsigned short bf16_t;
typedef short bf16x8 __attribute__((ext_vector_type(8)));
typedef float f32x4 __attribute__((ext_vector_type(4)));
typedef unsigned u32x4 __attribute__((ext_vector_type(4)));
constexpr int BM = 256, BK = 64, HALF = 128, HTB = HALF * BK * 2  , STAGE_BYTES = 8 * HTB, NXCD = 8, WGM = 8;

__host__ __device__ __forceinline__ int lds_byte(int r, int c) { const int st = (r >> 4) * 2 + (c >> 5), rr = r & 15, cc = c & 31, ob = rr * 64 + cc * 2; return st * 1024 + (ob ^ (((ob >> 9) & 1) << 5)); }
__host__ __device__ __forceinline__ void stage_rc(int b, int& R, int& C) { const int st = b / 1024, sb = b % 1024, swz = sb ^ (((sb >> 9) & 1) << 5); R = (st >> 1) * 16 + swz / 64; C = (st & 1) * 32 + (swz % 64) / 2; }
__host__ __device__ __forceinline__ int perm32(int rho) { const int n = rho >> 4, i = rho & 15; return 8 * (i >> 2) + 4 * n + (i & 3); }

struct Unit { int pm, pn; };
struct Gemm { const bf16_t* A; const bf16_t* Bt; int M, N, K; };

struct StaticOrder {
    int nM, nN, nwg, G, c;
    __host__ __device__ void init(int M, int N, int G_, int c_) { nM = M / BM; nN = N / BM; nwg = nM * nN; G = G_; c = c_; }
    __host__ __device__ bool next(int i, Unit& u) const {
        const long L = (long)i * G + c; if (L >= nwg) return false;
        int wgid = (int)L; { const int q = nwg / NXCD, r = nwg % NXCD, xcd = wgid % NXCD, off = wgid / NXCD; wgid = (xcd < r ? xcd * (q + 1) : r * (q + 1) + (xcd - r) * q) + off; }
        const int nig = WGM * nN, gid = wgid / nig, fm = gid * WGM, gsz = (nM - fm) < WGM ? (nM - fm) : WGM;
        u.pm = fm + ((wgid % nig) % gsz); u.pn = (wgid % nig) / gsz; return true;
    }
    __device__ __forceinline__ void a_ready(const Unit&) const {}
    __device__ __forceinline__ void done(const Unit&) const {}
};

__device__ __forceinline__ unsigned cvt_pk_bf16(float lo, float hi) { unsigned r; asm volatile("v_cvt_pk_bf16_f32 %0, %1, %2" : "=v"(r) : "v"(lo), "v"(hi)); return r; }
typedef float f32x2 __attribute__((ext_vector_type(2)));
typedef unsigned u32x2 __attribute__((ext_vector_type(2)));
__device__ __forceinline__ float bf_lo(unsigned w) { return __uint_as_float(w << 16); }
__device__ __forceinline__ float bf_hi(unsigned w) { return __uint_as_float(w & 0xffff0000u); }
__device__ __forceinline__ float sigmoid_f(float x) { return __builtin_amdgcn_rcpf(1.0f + __builtin_amdgcn_exp2f(x * -1.4426950408889634f)); }
__device__ __forceinline__ float gelu_tanh_f(float x) { const float z = x * (1.5957691216057308f + 0.07135481627f * x * x); return x * sigmoid_f(z); }
__device__ __forceinline__ float silu_f(float x) { return x * sigmoid_f(x); }

struct EpiIn {
    static constexpr bool PERM = true, AFTER_DRAIN = false;
    bf16_t* P; const float* rcos; const float* rsin; f32x2* vstat;
    __device__ __forceinline__ void operator()(const f32x4 (&acc)[2][2][4][2], const Unit& u, int wr, int wc, int fr, int fq) const {
        const int pn = u.pn; const int row0 = u.pm * BM + wr * 64 + fr; const int colw = pn * BM + wc * 32 + 8 * fq;
        if (pn < 8) {
#pragma unroll
            for (int ai = 0; ai < 2; ++ai)
#pragma unroll
                for (int m = 0; m < 4; ++m) { const int row = row0 + ai * HALF + m * 16; bf16_t* rowp = P + (size_t)row * 9216 + colw;
                    float g[2][8];
#pragma unroll
                    for (int bj = 0; bj < 2; ++bj) {
#pragma unroll
                        for (int i = 0; i < 4; ++i) { g[bj][i] = gelu_tanh_f(acc[ai][bj][m][0][i]); g[bj][4 + i] = gelu_tanh_f(acc[ai][bj][m][1][i]); }
                        u32x4 w; w.x = cvt_pk_bf16(g[bj][0], g[bj][1]); w.y = cvt_pk_bf16(g[bj][2], g[bj][3]); w.z = cvt_pk_bf16(g[bj][4], g[bj][5]); w.w = cvt_pk_bf16(g[bj][6], g[bj][7]);
                        *(u32x4*)(rowp + bj * HALF) = w; }
                    if (pn >= 4) {
                        float s = 0.f;
#pragma unroll
                        for (int bj = 0; bj < 2; ++bj)
#pragma unroll
                            for (int i = 0; i < 8; ++i) s += g[bj][i];
                        s += __shfl_xor(s, 16); s += __shfl_xor(s, 32);
                        const float mw = s * (1.0f / 64.0f); float q = 0.f;
#pragma unroll
                        for (int bj = 0; bj < 2; ++bj)
#pragma unroll
                            for (int i = 0; i < 8; ++i) { const float d = g[bj][i] - mw; q += d * d; }
                        q += __shfl_xor(q, 16); q += __shfl_xor(q, 32);
                        if (fq == 0) vstat[(size_t)row * 16 + (pn - 4) * 4 + wc] = (f32x2){mw, q};
                    } }
        } else if (pn < 16) {
#pragma unroll
            for (int ai = 0; ai < 2; ++ai)
#pragma unroll
                for (int m = 0; m < 4; ++m) { const int row = row0 + ai * HALF + m * 16; const int pos = row & 4095; bf16_t* rowp = P + (size_t)row * 9216 + colw;
#pragma unroll
                    for (int bj = 0; bj < 2; ++bj) { const int pr0 = ((colw + bj * HALF) & 63) >> 1;
                        const f32x4 cs = *(const f32x4*)(rcos + pos * 32 + pr0), sn = *(const f32x4*)(rsin + pos * 32 + pr0);
                        const f32x4 v0 = acc[ai][bj][m][0], v1 = acc[ai][bj][m][1];
                        u32x4 w;
                        w.x = cvt_pk_bf16(v0[0] * cs[0] - v0[1] * sn[0], v0[1] * cs[0] + v0[0] * sn[0]);
                        w.y = cvt_pk_bf16(v0[2] * cs[1] - v0[3] * sn[1], v0[3] * cs[1] + v0[2] * sn[1]);
                        w.z = cvt_pk_bf16(v1[0] * cs[2] - v1[1] * sn[2], v1[1] * cs[2] + v1[0] * sn[2]);
                        w.w = cvt_pk_bf16(v1[2] * cs[3] - v1[3] * sn[3], v1[3] * cs[3] + v1[2] * sn[3]);
                        *(u32x4*)(rowp + bj * HALF) = w; } }
        } else {
            const bool sg = pn >= 20;
#pragma unroll
            for (int ai = 0; ai < 2; ++ai)
#pragma unroll
                for (int m = 0; m < 4; ++m) { const int row = row0 + ai * HALF + m * 16; bf16_t* rowp = P + (size_t)row * 9216 + colw;
#pragma unroll
                    for (int bj = 0; bj < 2; ++bj) { f32x4 v0 = acc[ai][bj][m][0], v1 = acc[ai][bj][m][1];
                        if (sg) {
#pragma unroll
                            for (int i = 0; i < 4; ++i) { v0[i] = sigmoid_f(v0[i]); v1[i] = sigmoid_f(v1[i]); } }
                        u32x4 w; w.x = cvt_pk_bf16(v0[0], v0[1]); w.y = cvt_pk_bf16(v0[2], v0[3]); w.z = cvt_pk_bf16(v1[0], v1[1]); w.w = cvt_pk_bf16(v1[2], v1[3]);
                        *(u32x4*)(rowp + bj * HALF) = w; } }
        }
    }
};

template <int PASS> struct EpiUp {
    static constexpr bool PERM = true, AFTER_DRAIN = false;
    bf16_t* MG; const bf16_t* P; int gcol0;
    __device__ __forceinline__ void operator()(const f32x4 (&acc)[2][2][4][2], const Unit& u, int wr, int wc, int fr, int fq) const {
        const int row0 = u.pm * BM + wr * 64 + fr; const int colw = u.pn * BM + wc * 32 + 8 * fq;
#pragma unroll
        for (int ai = 0; ai < 2; ++ai)
#pragma unroll
            for (int m = 0; m < 4; ++m) { const int row = row0 + ai * HALF + m * 16; bf16_t* mrow = MG + (size_t)row * 2048 + colw; const bf16_t* grow = P + (size_t)row * 9216 + gcol0 + colw;
#pragma unroll
                for (int bj = 0; bj < 2; ++bj) { const u32x4 gw = *(const u32x4*)(grow + bj * HALF);
                    const f32x4 v0 = acc[ai][bj][m][0], v1 = acc[ai][bj][m][1];
                    float o[8] = {v0[0] * bf_lo(gw.x), v0[1] * bf_hi(gw.x), v0[2] * bf_lo(gw.y), v0[3] * bf_hi(gw.y), v1[0] * bf_lo(gw.z), v1[1] * bf_hi(gw.z), v1[2] * bf_lo(gw.w), v1[3] * bf_hi(gw.w)};
                    if (PASS == 1) { const u32x4 pw = *(const u32x4*)(mrow + bj * HALF);
                        o[0] += bf_lo(pw.x); o[1] += bf_hi(pw.x); o[2] += bf_lo(pw.y); o[3] += bf_hi(pw.y); o[4] += bf_lo(pw.z); o[5] += bf_hi(pw.z); o[6] += bf_lo(pw.w); o[7] += bf_hi(pw.w); }
                    u32x4 w; w.x = cvt_pk_bf16(o[0], o[1]); w.y = cvt_pk_bf16(o[2], o[3]); w.z = cvt_pk_bf16(o[4], o[5]); w.w = cvt_pk_bf16(o[6], o[7]);
                    *(u32x4*)(mrow + bj * HALF) = w; } }
    }
};

struct EpiRes {
    static constexpr bool PERM = false, AFTER_DRAIN = false;
    const float* xi; float* xo; const float* gate; int gstride;
    __device__ __forceinline__ void operator()(const f32x4 (&acc)[2][2][4][2], const Unit& u, int wr, int wc, int fr, int fq) const {
        const int row0 = u.pm * BM + wr * 64 + fr; const int col0 = u.pn * BM + wc * 32 + 4 * fq;
        const float* gb = gate + (size_t)((u.pm * BM) >> 12) * gstride + col0;
        f32x4 gv[2][2];
#pragma unroll
        for (int bj = 0; bj < 2; ++bj)
#pragma unroll
            for (int n = 0; n < 2; ++n) gv[bj][n] = *(const f32x4*)(gb + bj * HALF + n * 16);
#pragma unroll
        for (int ai = 0; ai < 2; ++ai)
#pragma unroll
            for (int m = 0; m < 4; ++m) { const size_t off = (size_t)(row0 + ai * HALF + m * 16) * 2048 + col0;
#pragma unroll
                for (int bj = 0; bj < 2; ++bj)
#pragma unroll
                    for (int n = 0; n < 2; ++n) { const f32x4 xv = *(const f32x4*)(xi + off + bj * HALF + n * 16);
                        *(f32x4*)(xo + off + bj * HALF + n * 16) = xv + gv[bj][n] * acc[ai][bj][m][n]; } }
    }
};

struct EpiSwiglu {
    static constexpr bool PERM = true, AFTER_DRAIN = false;
    bf16_t* T;
    __device__ __forceinline__ void operator()(const f32x4 (&acc)[2][2][4][2], const Unit& u, int wr, int wc, int fr, int fq) const {
        const int row0 = u.pm * BM + wr * 64 + fr; const int colw = u.pn * HALF + wc * 32 + 8 * fq;
#pragma unroll
        for (int ai = 0; ai < 2; ++ai)
#pragma unroll
            for (int m = 0; m < 4; ++m) { bf16_t* rowp = T + (size_t)(row0 + ai * HALF + m * 16) * 5632 + colw;
                const f32x4 a0 = acc[ai][0][m][0], a1 = acc[ai][0][m][1], b0 = acc[ai][1][m][0], b1 = acc[ai][1][m][1];
                u32x4 w; w.x = cvt_pk_bf16(silu_f(a0[0]) * b0[0], silu_f(a0[1]) * b0[1]); w.y = cvt_pk_bf16(silu_f(a0[2]) * b0[2], silu_f(a0[3]) * b0[3]);
                w.z = cvt_pk_bf16(silu_f(a1[0]) * b1[0], silu_f(a1[1]) * b1[1]); w.w = cvt_pk_bf16(silu_f(a1[2]) * b1[2], silu_f(a1[3]) * b1[3]);
                *(u32x4*)rowp = w; }
    }
};
template <class Epi, class Sched, bool ALIGN_EPI = false, bool SP2 = false>
__device__ __forceinline__ void gemm_phase(PG8_LAS unsigned char* lds, const Gemm g, const Sched& S, const Epi& E) {
    int tid_ = threadIdx.x; asm volatile("" : "+v"(tid_));
    const int tid = tid_, wid = __builtin_amdgcn_readfirstlane(tid >> 6), lane = tid & 63, wr = wid >> 2, wc = wid & 3, fr = lane & 15, fq = lane >> 4;
    const int K = g.K, nt = K / BK;
    unsigned voffA[2], voffB[2];
#pragma unroll
    for (int i = 0; i < 2; ++i) { int R, C; stage_rc(tid * 16 + i * 8192, R, C); const int Rb = Epi::PERM ? ((R & ~31) + perm32(R & 31)) : R;
        voffA[i] = (unsigned)(R * K + C) * 2u; voffB[i] = (unsigned)(Rb * K + C) * 2u; }
    const size_t kstep = (size_t)(BK * 2);
    const size_t hstep = (size_t)HALF * K * 2;
    const size_t tstep = 2 * hstep;
    const unsigned ldsw = (unsigned)wid * 1024u;
    const int aoff = lds_byte(wr * 64 + fr, fq * 8), boff = lds_byte(wc * 32 + fr, fq * 8);
#define PG8_SA(b, h) (((b) * 2 + (h)) * HTB)
#define PG8_SB(b, h) ((4 + (b) * 2 + (h)) * HTB)
#define PG8_STAGE(bufoff, gbase, voff) do { _Pragma("unroll") for (int _i = 0; _i < 2; ++_i) \
        __builtin_amdgcn_global_load_lds((const unsigned*)((const char*)(gbase) + (voff)[_i]), (PG8_LAS unsigned*)(lds + (bufoff) + ldsw + _i * 8192), 16, 0, 0); } while (0)
#define PG8_LDA(dst, b, h) do { _Pragma("unroll") for (int m = 0; m < 4; ++m) _Pragma("unroll") for (int k = 0; k < 2; ++k) dst[m][k] = *(const PG8_LAS bf16x8*)(lds + PG8_SA(b, h) + aoff + m * 2048 + k * 1024); } while (0)
#define PG8_LDB(dst, b, h) do { _Pragma("unroll") for (int n = 0; n < 2; ++n) _Pragma("unroll") for (int k = 0; k < 2; ++k) dst[n][k] = *(const PG8_LAS bf16x8*)(lds + PG8_SB(b, h) + boff + n * 2048 + k * 1024); } while (0)
#define PG8_MMA(ai, bj, At, Bt) do { __builtin_amdgcn_s_setprio(1); _Pragma("unroll") for (int m = 0; m < 4; ++m) _Pragma("unroll") for (int n = 0; n < 2; ++n) _Pragma("unroll") for (int k = 0; k < 2; ++k) \
        acc[ai][bj][m][n] = __builtin_amdgcn_mfma_f32_16x16x32_bf16(Bt[n][k], At[m][k], acc[ai][bj][m][n], 0, 0, 0); __builtin_amdgcn_s_setprio(0); } while (0)
#define PG8_WAIT_V(n) asm volatile("s_waitcnt vmcnt(" #n ")" ::: "memory")
#define PG8_WAIT_L(n) asm volatile("s_waitcnt lgkmcnt(" #n ")" ::: "memory")
#define PG8_BAR __builtin_amdgcn_s_barrier()
#define PG8_SCHED __builtin_amdgcn_sched_barrier(0)
    Unit cur, nxt; int ui = 0;
    if (!S.next(0, cur)) return;
    f32x4 acc[2][2][4][2];
#pragma unroll
    for (int a = 0; a < 2; ++a)
#pragma unroll
        for (int b = 0; b < 2; ++b)
#pragma unroll
            for (int m = 0; m < 4; ++m)
#pragma unroll
                for (int n = 0; n < 2; ++n) acc[a][b][m][n] = (f32x4){0.f, 0.f, 0.f, 0.f};
    bf16x8 At[4][2], B0[2][2], B1[2][2];
    const char* cA = (const char*)g.A + (size_t)cur.pm * tstep; const char* cB = (const char*)g.Bt + (size_t)cur.pn * tstep;
    S.a_ready(cur);
    if constexpr (SP2) {
        PG8_STAGE(PG8_SB(0, 0), cB, voffB); PG8_STAGE(PG8_SB(0, 1), cB + hstep, voffB); PG8_STAGE(PG8_SA(0, 0), cA, voffA); PG8_STAGE(PG8_SA(0, 1), cA + hstep, voffA);
        if (wr == 1) PG8_BAR;
        PG8_WAIT_V(2); PG8_BAR;
        PG8_STAGE(PG8_SB(1, 0), cB + kstep, voffB); PG8_STAGE(PG8_SA(1, 0), cA + kstep, voffA); PG8_STAGE(PG8_SB(1, 1), cB + hstep + kstep, voffB);
        PG8_WAIT_V(6); PG8_BAR;
    } else {
        PG8_STAGE(PG8_SB(0, 0), cB, voffB); PG8_STAGE(PG8_SA(0, 0), cA, voffA); PG8_STAGE(PG8_SB(0, 1), cB + hstep, voffB); PG8_STAGE(PG8_SA(0, 1), cA + hstep, voffA);
        if (wr == 1) PG8_BAR;
        PG8_WAIT_V(4); PG8_BAR;
        PG8_STAGE(PG8_SB(1, 0), cB + kstep, voffB); PG8_STAGE(PG8_SA(1, 0), cA + kstep, voffA); PG8_STAGE(PG8_SB(1, 1), cB + hstep + kstep, voffB);
        PG8_WAIT_V(6); PG8_BAR;
    }
    for (;;) {
        const bool has_next = S.next(ui + 1, nxt);
        const char* nA = has_next ? (const char*)g.A + (size_t)nxt.pm * tstep : cA; const char* nB = has_next ? (const char*)g.Bt + (size_t)nxt.pn * tstep : cB;
        for (int t = 0; t < nt; t += 2) {
            const bool last = (t == nt - 2);
            const char* a1 = cA + (size_t)(t + 1) * kstep;
            const char* a2 = last ? nA : cA + (size_t)(t + 2) * kstep; const char* b2 = last ? nB : cB + (size_t)(t + 2) * kstep;
            const char* a3 = a2 + kstep; const char* b3 = b2 + kstep;
            if (last && has_next) S.a_ready(nxt);
            if constexpr (SP2) {
            PG8_LDB(B0, 0, 0); PG8_LDB(B1, 0, 1); PG8_SCHED; PG8_LDA(At, 0, 0); PG8_STAGE(PG8_SA(1, 1), a1 + hstep, voffA);
            PG8_WAIT_V(8); PG8_WAIT_L(0); PG8_BAR; PG8_MMA(0, 0, At, B0); PG8_MMA(0, 1, At, B1); PG8_BAR; PG8_SCHED;
            PG8_LDA(At, 0, 1); PG8_STAGE(PG8_SB(0, 0), b2, voffB); PG8_STAGE(PG8_SB(0, 1), b2 + hstep, voffB); PG8_STAGE(PG8_SA(0, 0), a2, voffA);
            PG8_WAIT_V(8); PG8_WAIT_L(0); PG8_BAR; PG8_MMA(1, 0, At, B0); PG8_MMA(1, 1, At, B1); PG8_BAR; PG8_SCHED;
            PG8_LDB(B0, 1, 0); PG8_LDB(B1, 1, 1); PG8_SCHED; PG8_LDA(At, 1, 0); PG8_STAGE(PG8_SA(0, 1), a2 + hstep, voffA);
            PG8_WAIT_V(8); PG8_WAIT_L(0); PG8_BAR; PG8_MMA(0, 0, At, B0); PG8_MMA(0, 1, At, B1); PG8_BAR; PG8_SCHED;
            PG8_LDA(At, 1, 1); PG8_STAGE(PG8_SB(1, 0), b3, voffB); PG8_STAGE(PG8_SB(1, 1), b3 + hstep, voffB); PG8_STAGE(PG8_SA(1, 0), a3, voffA);
            PG8_WAIT_V(8); PG8_WAIT_L(0); PG8_BAR; PG8_MMA(1, 0, At, B0); PG8_MMA(1, 1, At, B1); PG8_BAR; PG8_SCHED;
            } else {
            PG8_LDB(B0, 0, 0); PG8_SCHED; PG8_LDA(At, 0, 0); PG8_STAGE(PG8_SA(1, 1), a1 + hstep, voffA);
            PG8_WAIT_L(8); PG8_BAR; PG8_WAIT_L(0); PG8_MMA(0, 0, At, B0); PG8_BAR; PG8_SCHED;
            PG8_LDB(B1, 0, 1); PG8_STAGE(PG8_SB(0, 0), b2, voffB);
            PG8_BAR; PG8_WAIT_L(0); PG8_MMA(0, 1, At, B1); PG8_BAR;
            PG8_LDA(At, 0, 1); PG8_STAGE(PG8_SA(0, 0), a2, voffA);
            PG8_BAR; PG8_WAIT_L(0); PG8_MMA(1, 0, At, B0); PG8_BAR; PG8_SCHED;
            PG8_STAGE(PG8_SB(0, 1), b2 + hstep, voffB);
            PG8_WAIT_V(6); PG8_BAR; PG8_MMA(1, 1, At, B1); PG8_BAR;
            PG8_LDB(B0, 1, 0); PG8_SCHED; PG8_LDA(At, 1, 0); PG8_STAGE(PG8_SA(0, 1), a2 + hstep, voffA);
            PG8_WAIT_L(8); PG8_BAR; PG8_WAIT_L(0); PG8_MMA(0, 0, At, B0); PG8_BAR; PG8_SCHED;
            PG8_LDB(B1, 1, 1); PG8_STAGE(PG8_SB(1, 0), b3, voffB);
            PG8_BAR; PG8_WAIT_L(0); PG8_MMA(0, 1, At, B1); PG8_BAR;
            PG8_LDA(At, 1, 1); PG8_STAGE(PG8_SA(1, 0), a3, voffA);
            PG8_BAR; PG8_WAIT_L(0); PG8_MMA(1, 0, At, B0); PG8_BAR; PG8_SCHED;
            PG8_STAGE(PG8_SB(1, 1), b3 + hstep, voffB);
            PG8_WAIT_V(6); PG8_BAR; PG8_MMA(1, 1, At, B1); PG8_BAR;
            }
        }
        if constexpr (ALIGN_EPI) { if (wr == 0) PG8_BAR; }
        if constexpr (!Epi::AFTER_DRAIN) { E(acc, cur, wr, wc, fr, fq); S.done(cur); }
        if (!has_next) break;
#pragma unroll
        for (int a = 0; a < 2; ++a)
#pragma unroll
            for (int b = 0; b < 2; ++b)
#pragma unroll
                for (int m = 0; m < 4; ++m)
#pragma unroll
                    for (int n = 0; n < 2; ++n) acc[a][b][m][n] = (f32x4){0.f, 0.f, 0.f, 0.f};
        cur = nxt; cA = nA; cB = nB; ++ui;
        if constexpr (ALIGN_EPI) { if (wr == 1) PG8_BAR; }
    }
    PG8_WAIT_V(0);
    if constexpr (!ALIGN_EPI) { if (wr == 0) PG8_BAR; }
    PG8_BAR;
    if constexpr (Epi::AFTER_DRAIN) { E.fused(acc, cur, wr, wc, fr, fq, lds, wid, lane); S.done(cur); }
#undef PG8_SA
#undef PG8_SB
#undef PG8_STAGE
#undef PG8_LDA
#undef PG8_LDB
#undef PG8_MMA
#undef PG8_WAIT_V
#undef PG8_WAIT_L
#undef PG8_BAR
#undef PG8_SCHED
}
}
namespace att {
#define ATT_LAS __attribute__((address_space(3)))
typedef unsigned short bf16_t;
using bf16x8 = __attribute__((ext_vector_type(8))) short;
using s16x4  = __attribute__((ext_vector_type(4))) short;
using f32x16 = __attribute__((ext_vector_type(16))) float;
using f32x4v = __attribute__((ext_vector_type(4))) float;
using f32x2v = __attribute__((ext_vector_type(2))) float;
using u32x4  = __attribute__((ext_vector_type(4))) unsigned;
constexpr int KVBLK = 64, LDP = 9216, SEQL = 4096;
constexpr int PC_U = 0, PC_V = 1024, PC_Q = 2048, PC_K = 3072, PC_VA = 4096;
constexpr float SCALE = 0.125f;
constexpr float THR = 8.f;
constexpr int SHM_V = KVBLK * 128 * 2, SHM_K = KVBLK * 128 * 2, SHM_ATTN = 2 * SHM_V + 2 * SHM_K + 8 * 64 * 4;
#define KSWZ(row, colB) ((row) * 256 + ((colB) ^ (((row) & 7) << 4)))
#define SBAR() __builtin_amdgcn_sched_barrier(0)
__device__ __forceinline__ int crow(int r, int hi) { return (r & 3) + 8 * (r >> 2) + 4 * hi; }
__device__ __forceinline__ unsigned cvtpk(float lo, float hi) { unsigned r; asm volatile("v_cvt_pk_bf16_f32 %0, %1, %2" : "=v"(r) : "v"(lo), "v"(hi)); return r; }
__device__ __forceinline__ bf16x8 ld8(const bf16_t* p) { return *reinterpret_cast<const bf16x8*>(p); }
__device__ __forceinline__ float bf2f(short h) { return __uint_as_float(((unsigned)(unsigned short)h) << 16); }

__device__ __forceinline__ void partialSM(f32x16& p0, f32x16& p1, float& m_reg, float& mn, float& alpha) {
  constexpr float C = SCALE * 1.4426950408889634f;
  float pmax = p0[0];
#pragma unroll
  for (int r = 1; r < 16; ++r) pmax = fmaxf(pmax, p0[r]);
#pragma unroll
  for (int r = 0; r < 16; ++r) pmax = fmaxf(pmax, p1[r]);
  { auto rr = __builtin_amdgcn_permlane32_swap(__float_as_uint(pmax), __float_as_uint(pmax), false, false);
    pmax = fmaxf(__uint_as_float(rr[0]), __uint_as_float(rr[1])); }
  if (__builtin_expect(__all(pmax - m_reg <= THR / SCALE), 1)) { mn = m_reg; alpha = 1.f; }
  else { mn = fmaxf(m_reg, pmax); alpha = __builtin_amdgcn_exp2f((m_reg - mn) * C); m_reg = mn; }
  float mnC = -mn * C;
#pragma unroll
  for (int r = 0; r < 16; ++r) p0[r] = fmaf(p0[r], C, mnC);
#pragma unroll
  for (int r = 0; r < 16; ++r) p1[r] = fmaf(p1[r], C, mnC);
#pragma unroll
  for (int r = 0; r < 16; ++r) p0[r] = __builtin_amdgcn_exp2f(p0[r]);
}
__device__ __forceinline__ void finishSM(f32x16& p0, f32x16& p1, float alpha, float& l_reg, bf16x8& pa0, bf16x8& pa1, bf16x8& pa2, bf16x8& pa3) {
#pragma unroll
  for (int r = 0; r < 16; ++r) p1[r] = __builtin_amdgcn_exp2f(p1[r]);
  float ps = 0;
#pragma unroll
  for (int r = 0; r < 16; ++r) ps += p0[r];
#pragma unroll
  for (int r = 0; r < 16; ++r) ps += p1[r];
  { auto rr = __builtin_amdgcn_permlane32_swap(__float_as_uint(ps), __float_as_uint(ps), false, false);
    ps = __uint_as_float(rr[0]) + __uint_as_float(rr[1]); }
  l_reg = l_reg * alpha + ps;
#define PK4(P, BASE, OUT) do { unsigned a0 = cvtpk(P[BASE + 0], P[BASE + 1]), a1 = cvtpk(P[BASE + 2], P[BASE + 3]);   \
    unsigned b0 = cvtpk(P[BASE + 4], P[BASE + 5]), b1 = cvtpk(P[BASE + 6], P[BASE + 7]);                              \
    auto r0 = __builtin_amdgcn_permlane32_swap(a0, b0, false, false); auto r1 = __builtin_amdgcn_permlane32_swap(a1, b1, false, false); \
    u32x4 w = {r0[0], r1[0], r0[1], r1[1]}; OUT = *reinterpret_cast<bf16x8*>(&w); } while (0)
  PK4(p0, 0, pa0); PK4(p0, 8, pa1); PK4(p1, 0, pa2); PK4(p1, 8, pa3);
#undef PK4
}
__device__ __forceinline__ void qkt(f32x16& p0, f32x16& p1, const ATT_LAS char* Ks, const bf16x8* qr, int r32, int hi, int colb0) {
  p0 = f32x16{}; p1 = f32x16{};
#pragma unroll
  for (int d0 = 0; d0 < 4; ++d0) { const int cb = colb0 + (d0 * 16 + hi * 8) * 2;
    const bf16x8 b0 = *reinterpret_cast<const ATT_LAS bf16x8*>(Ks + KSWZ(r32, cb));
    const bf16x8 b1 = *reinterpret_cast<const ATT_LAS bf16x8*>(Ks + KSWZ(32 + r32, cb));
    p0 = __builtin_amdgcn_mfma_f32_32x32x16_bf16(b0, qr[d0], p0, 0, 0, 0);
    p1 = __builtin_amdgcn_mfma_f32_32x32x16_bf16(b1, qr[d0], p1, 0, 0, 0); }
}
__device__ __forceinline__ int v_st(int k, int c) { const int kk = (k & ~0xC) | ((k & 4) << 1) | ((k & 8) >> 1); return ((kk >> 3) * 4 + (c >> 5)) * 512 + ((kk & 7) * 32 + (c & 31)) * 2; }
__device__ __forceinline__ int v_rd_base(int lane) { return ((lane & 3) << 3) | (((lane >> 2) & 3) << 6) | (((lane >> 4) & 1) << 5) | (((lane >> 5) & 1) << 8); }
constexpr int v_rd_off(int d0, int ks, int half) { return d0 * 512 + ks * 4096 + half * 2048; }
template <int OFF> __device__ __forceinline__ s16x4 tr_read(int vb) {
  s16x4 r; asm volatile("ds_read_b64_tr_b16 %0, %1 offset:%2" : "=&v"(r) : "v"(vb), "i"(OFF) : "memory"); return r;
}
template <int D0> __device__ __forceinline__ void pv_one(f32x16& od, int vb, bf16x8 pa0, bf16x8 pa1, bf16x8 pa2, bf16x8 pa3) {
  const s16x4 l0 = tr_read<v_rd_off(D0, 0, 0)>(vb), h0 = tr_read<v_rd_off(D0, 0, 1)>(vb), l1 = tr_read<v_rd_off(D0, 1, 0)>(vb), h1 = tr_read<v_rd_off(D0, 1, 1)>(vb);
  const s16x4 l2 = tr_read<v_rd_off(D0, 2, 0)>(vb), h2 = tr_read<v_rd_off(D0, 2, 1)>(vb), l3 = tr_read<v_rd_off(D0, 3, 0)>(vb), h3 = tr_read<v_rd_off(D0, 3, 1)>(vb);
  asm volatile("s_waitcnt lgkmcnt(0)" ::: "memory"); SBAR();
#define PK(L, H) (bf16x8){L[0], L[1], L[2], L[3], H[0], H[1], H[2], H[3]}
  od = __builtin_amdgcn_mfma_f32_32x32x16_bf16(pa0, PK(l0, h0), od, 0, 0, 0);
  od = __builtin_amdgcn_mfma_f32_32x32x16_bf16(pa1, PK(l1, h1), od, 0, 0, 0);
  od = __builtin_amdgcn_mfma_f32_32x32x16_bf16(pa2, PK(l2, h2), od, 0, 0, 0);
  od = __builtin_amdgcn_mfma_f32_32x32x16_bf16(pa3, PK(l3, h3), od, 0, 0, 0);
#undef PK
}
__device__ __forceinline__ void pv_d0(f32x16* o, int vb, bf16x8 pa0, bf16x8 pa1, bf16x8 pa2, bf16x8 pa3) {
  pv_one<0>(o[0], vb, pa0, pa1, pa2, pa3); pv_one<1>(o[1], vb, pa0, pa1, pa2, pa3); pv_one<2>(o[2], vb, pa0, pa1, pa2, pa3); pv_one<3>(o[3], vb, pa0, pa1, pa2, pa3);
}

__device__ __forceinline__ void attn_unit(const bf16_t* __restrict__ P, bf16_t* __restrict__ BRB, int b, int h, int qb, float lam, float oml, const float* __restrict__ subg, ATT_LAS char* lds) {
  int tid_ = threadIdx.x; asm volatile("" : "+v"(tid_));
  const int tid = tid_, wid = __builtin_amdgcn_readfirstlane(tid >> 6), lane = tid & 63, r32 = lane & 31, hi = lane >> 5;
  const int map = wid >> 2, wq = wid & 3, colb0 = map * 128;
  ATT_LAS char* V_lds = lds; ATT_LAS char* K_lds = lds + 2 * SHM_V;
  ATT_LAS float* ws = (ATT_LAS float*)(lds + 2 * SHM_V + 2 * SHM_K) + wid * 64; ATT_LAS float* li_l = ws; ATT_LAS float* al_l = ws + 32;
  float m_reg = -1e30f, l_reg = 0; f32x16 o[4] = {}; bf16x8 qr[4];
  const size_t tok0 = (size_t)b * SEQL + (size_t)qb * 128;
  const bf16_t* Qw = P + (tok0 + wq * 32 + r32) * LDP + PC_Q + h * 128 + map * 64 + hi * 8;
#pragma unroll
  for (int d0 = 0; d0 < 4; ++d0) qr[d0] = ld8(Qw + d0 * 16);
  const bf16_t* Kh = P + (size_t)b * SEQL * LDP + PC_K + h * 128;
  const bf16_t* Vh = P + (size_t)b * SEQL * LDP + PC_VA + h * 128;
  const int sr = tid >> 4, sc = (tid & 15) * 8, vst0 = v_st(sr, sc), vst1 = v_st(32 + sr, sc);
  const int vb0 = (int)(uintptr_t)V_lds + v_rd_base(lane);
  struct { bf16x8 vs0, vs1, ks0, ks1; } sr_[2];
#define SLOAD(i, k0) do { sr_[i].vs0 = ld8(&Vh[(size_t)((k0) + sr) * LDP + sc]); sr_[i].vs1 = ld8(&Vh[(size_t)((k0) + 32 + sr) * LDP + sc]); \
    sr_[i].ks0 = ld8(&Kh[(size_t)((k0) + sr) * LDP + sc]); sr_[i].ks1 = ld8(&Kh[(size_t)((k0) + 32 + sr) * LDP + sc]); } while (0)
#define SWRITE(bb, i) do { *(ATT_LAS bf16x8*)(V_lds + (bb) * SHM_V + vst0) = sr_[i].vs0;          \
    *(ATT_LAS bf16x8*)(V_lds + (bb) * SHM_V + vst1) = sr_[i].vs1; const int kc = sc * 2;               \
    *(ATT_LAS bf16x8*)(K_lds + (bb) * SHM_K + KSWZ(sr, kc)) = sr_[i].ks0;                       \
    *(ATT_LAS bf16x8*)(K_lds + (bb) * SHM_K + KSWZ(32 + sr, kc)) = sr_[i].ks1; } while (0)
#define SWAIT() asm volatile("s_waitcnt vmcnt(4)" ::: "memory")
#define RESC(a) do { if (__any((a) < 1.f)) { if (hi == 0) al_l[r32] = (a); asm volatile("s_waitcnt lgkmcnt(0)" ::: "memory"); \
    _Pragma("unroll") for (int d = 0; d < 4; ++d) _Pragma("unroll") for (int r = 0; r < 16; ++r) o[d][r] *= al_l[crow(r, hi)]; } } while (0)
  f32x16 pA0, pA1, pB0, pB1; float mnA, mnB, alA, alB; bf16x8 pa0, pa1, pa2, pa3; constexpr int NT = SEQL / KVBLK;
  constexpr int SE = 0, SO = 1;
  SLOAD(SE, 0); asm volatile("s_waitcnt vmcnt(0)" ::: "memory"); SWRITE(0, SE); __syncthreads();
  qkt(pA0, pA1, K_lds, qr, r32, hi, colb0); partialSM(pA0, pA1, m_reg, mnA, alA);
  SLOAD(SO, KVBLK); SLOAD(SE, 2 * KVBLK);
  SWAIT(); SWRITE(1, SO); __syncthreads();
  for (int j = 1; j + 1 < NT; j += 2) {
    SBAR(); qkt(pB0, pB1, K_lds + SHM_K, qr, r32, hi, colb0);
    finishSM(pA0, pA1, alA, l_reg, pa0, pa1, pa2, pa3); SBAR();
    SLOAD(SO, (j + 2) * KVBLK); SBAR();
    pv_d0(o, vb0, pa0, pa1, pa2, pa3); partialSM(pB0, pB1, m_reg, mnB, alB);
    __syncthreads(); SWAIT(); SWRITE(0, SE);
    RESC(alB); __syncthreads();
    SBAR(); qkt(pA0, pA1, K_lds, qr, r32, hi, colb0);
    finishSM(pB0, pB1, alB, l_reg, pa0, pa1, pa2, pa3); SBAR();
    if (j + 3 < NT) SLOAD(SE, (j + 3) * KVBLK);
    SBAR();
    pv_d0(o, vb0 + SHM_V, pa0, pa1, pa2, pa3); partialSM(pA0, pA1, m_reg, mnA, alA);
    __syncthreads(); SWAIT(); SWRITE(1, SO);
    RESC(alA); __syncthreads();
  }
  SBAR(); qkt(pB0, pB1, K_lds + SHM_K, qr, r32, hi, colb0);
  finishSM(pA0, pA1, alA, l_reg, pa0, pa1, pa2, pa3); SBAR();
  pv_d0(o, vb0, pa0, pa1, pa2, pa3); partialSM(pB0, pB1, m_reg, mnB, alB);
  __syncthreads(); RESC(alB);
  finishSM(pB0, pB1, alB, l_reg, pa0, pa1, pa2, pa3); SBAR();
  pv_d0(o, vb0 + SHM_V, pa0, pa1, pa2, pa3);
  if (hi == 0) li_l[r32] = l_reg; asm volatile("s_waitcnt lgkmcnt(0)" ::: "memory");
  float rli[16];
#pragma unroll
  for (int r = 0; r < 16; ++r) rli[r] = __builtin_amdgcn_rcpf(li_l[crow(r, hi)]);
  __syncthreads();
  int tid2 = threadIdx.x; asm volatile("" : "+v"(tid2));
  const int lane2 = tid2 & 63, r32b = lane2 & 31, hib = lane2 >> 5;
  ATT_LAS float* ex = (ATT_LAS float*)lds + wq * 4096 + lane2;
  if (map == 1) {
#pragma unroll
    for (int d0 = 0; d0 < 4; ++d0)
#pragma unroll
      for (int r = 0; r < 16; ++r) ex[(d0 * 16 + r) * 64] = o[d0][r] * rli[r] * lam;
  }
  __syncthreads();
  if (map == 0) {
    float ss[16];
#pragma unroll
    for (int r = 0; r < 16; ++r) ss[r] = 0.f;
#pragma unroll
    for (int d0 = 0; d0 < 4; ++d0)
#pragma unroll
      for (int r = 0; r < 16; ++r) { const float v = o[d0][r] * rli[r] - ex[(d0 * 16 + r) * 64]; o[d0][r] = v; ss[r] += v * v; }
#pragma unroll
    for (int r = 0; r < 16; ++r) {
      float s = ss[r];
      s += __shfl_xor(s, 1); s += __shfl_xor(s, 2); s += __shfl_xor(s, 4); s += __shfl_xor(s, 8); s += __shfl_xor(s, 16);
      ss[r] = oml / sqrtf(s * (1.0f / 128.0f) + 1e-6f);
    }
    bf16_t* Ow = BRB + (tok0 + wq * 32 + 4 * hib) * 1024 + h * 128 + r32b;
#pragma unroll
    for (int d0 = 0; d0 < 4; ++d0) { const float g = subg[d0 * 32 + r32b];
#pragma unroll
      for (int r = 0; r < 16; ++r) { const unsigned w = cvtpk(o[d0][r] * ss[r] * g, 0.f); Ow[(size_t)crow(r, 0) * 1024 + d0 * 32] = (bf16_t)(w & 0xffffu); } }
  }
  __syncthreads();
#undef SLOAD
#undef SWRITE
#undef SWAIT
#undef RESC
}

__device__ __forceinline__ void gmlp_unit(const bf16_t* __restrict__ P, bf16_t* __restrict__ BRA, const f32x2v* __restrict__ vstat, const bf16_t* __restrict__ WSb, const float* __restrict__ bs,
                                          const float* __restrict__ lng, const float* __restrict__ lnb, int b, int n, int g, ATT_LAS char* lds) {
  int tid_ = threadIdx.x; asm volatile("" : "+v"(tid_));
  const int tid = tid_, wid = __builtin_amdgcn_readfirstlane(tid >> 6), lane = tid & 63, r32 = lane & 31, hi = lane >> 5;
  const size_t tok0 = (size_t)b * SEQL + (size_t)n * 128; const int ch0 = g * 128;
  const int pblk = wid & 3, dpair = wid >> 2;
  ATT_LAS f32x2v* st = (ATT_LAS f32x2v*)(lds + 32768);
  bf16x8 af[8];
  { const bf16_t* wrow = WSb + ((size_t)g * 128 + pblk * 32 + r32) * 128 + hi * 8;
#pragma unroll
    for (int ks = 0; ks < 8; ++ks) af[ks] = ld8(wrow + ks * 16); }
  if (tid < 128) {
    const f32x4v* sp = (const f32x4v*)(vstat + (tok0 + tid) * 16); f32x4v t[8];
#pragma unroll
    for (int i = 0; i < 8; ++i) t[i] = sp[i];
    float ms = 0.f;
#pragma unroll
    for (int i = 0; i < 8; ++i) ms += t[i][0] + t[i][2];
    const float mean = ms * (1.0f / 16.0f); float m2 = 0.f;
#pragma unroll
    for (int i = 0; i < 8; ++i) { const float d0 = t[i][0] - mean, d1 = t[i][2] - mean; m2 += t[i][1] + t[i][3] + 64.0f * (d0 * d0 + d1 * d1); }
    st[tid] = (f32x2v){mean, 1.0f / sqrtf(m2 * (1.0f / 1024.0f) + 1e-6f)};
  }
  __syncthreads();
  { const int sr = tid >> 4, sc = (tid & 15) * 8;
    const f32x4v g0 = *(const f32x4v*)(lng + ch0 + sc), g1 = *(const f32x4v*)(lng + ch0 + sc + 4), b0 = *(const f32x4v*)(lnb + ch0 + sc), b1 = *(const f32x4v*)(lnb + ch0 + sc + 4);
#pragma unroll
    for (int j = 0; j < 4; ++j) { const int q = sr + 32 * j; const bf16x8 x = ld8(P + (tok0 + q) * LDP + PC_V + ch0 + sc); const f32x2v mr = st[q];
      u32x4 w;
      w.x = cvtpk((bf2f(x[0]) - mr.x) * mr.y * g0[0] + b0[0], (bf2f(x[1]) - mr.x) * mr.y * g0[1] + b0[1]);
      w.y = cvtpk((bf2f(x[2]) - mr.x) * mr.y * g0[2] + b0[2], (bf2f(x[3]) - mr.x) * mr.y * g0[3] + b0[3]);
      w.z = cvtpk((bf2f(x[4]) - mr.x) * mr.y * g1[0] + b1[0], (bf2f(x[5]) - mr.x) * mr.y * g1[1] + b1[1]);
      w.w = cvtpk((bf2f(x[6]) - mr.x) * mr.y * g1[2] + b1[2], (bf2f(x[7]) - mr.x) * mr.y * g1[3] + b1[3]);
      *(ATT_LAS u32x4*)(lds + (q >> 6) * SHM_V + v_st(q & 63, sc)) = w; } }
  __syncthreads();
  const int vb = (int)(uintptr_t)lds + v_rd_base(lane) + dpair * 1024;
  f32x16 o0 = {}, o1 = {};
  pv_one<0>(o0, vb, af[0], af[1], af[2], af[3]); pv_one<0>(o0, vb + SHM_V, af[4], af[5], af[6], af[7]);
  pv_one<1>(o1, vb, af[0], af[1], af[2], af[3]); pv_one<1>(o1, vb + SHM_V, af[4], af[5], af[6], af[7]);
  const float* bsg = bs + g * 128 + pblk * 32;
  const bf16_t* Up = P + (tok0 + pblk * 32) * LDP + PC_U + ch0 + dpair * 64 + r32;
  bf16_t* Op = BRA + (tok0 + pblk * 32) * 1024 + ch0 + dpair * 64 + r32;
#pragma unroll
  for (int r = 0; r < 16; ++r) { const int p = crow(r, hi); const float bb = bsg[p];
    const float u0 = bf2f((short)Up[(size_t)p * LDP]), u1 = bf2f((short)Up[(size_t)p * LDP + 32]);
    const unsigned w0 = cvtpk(u0 * (o0[r] + bb), 0.f), w1 = cvtpk(u1 * (o1[r] + bb), 0.f);
    Op[(size_t)p * 1024] = (bf16_t)(w0 & 0xffffu); Op[(size_t)p * 1024 + 32] = (bf16_t)(w1 & 0xffffu); }
  __syncthreads();
}
#undef KSWZ
#undef SBAR
}
#define GAS __attribute__((address_space(1)))
#define LAS __attribute__((address_space(3)))
typedef unsigned short bf16;
typedef unsigned v4u __attribute__((ext_vector_type(4)));
typedef float f32x4 __attribute__((ext_vector_type(4)));
typedef short bf16x8 __attribute__((ext_vector_type(8)));
typedef GAS unsigned gu32;
typedef GAS unsigned long long gu64;
#define RLX_AGENT __ATOMIC_RELAXED, __HIP_MEMORY_SCOPE_AGENT
#define LDS_WAIT() asm volatile("s_waitcnt lgkmcnt(0)" ::: "memory")
#define VM_WAIT() asm volatile("s_waitcnt vmcnt(0)" ::: "memory")
__device__ __forceinline__ unsigned long long rt() { return __builtin_amdgcn_s_memrealtime(); }
__device__ __forceinline__ unsigned f2bf(float f) { unsigned u = __builtin_bit_cast(unsigned, f); return (u + 0x7fffu + ((u >> 16) & 1u)) >> 16; }
__device__ __forceinline__ unsigned pk2(float lo, float hi) { return f2bf(lo) | (f2bf(hi) << 16); }

#define XB_TMO      128
#define XB_XCNT(j)  (256  + 64 * (j))
#define XB_XSUB(j)  (1280 + 64 * (j))
#define XB_XGEN(j)  (2304 + 64 * (j))
#define XB_TOP      3328
#define XB_TOPGEN   3392
#define XCD_BAR_WORDS 3456
#define XB_SPIN_CAP (1u << 18)

__device__ __forceinline__ unsigned xb_ld(unsigned* p)              { return __hip_atomic_load(p, __ATOMIC_RELAXED, __HIP_MEMORY_SCOPE_AGENT); }
__device__ __forceinline__ unsigned xb_add(unsigned* p, unsigned v) { return __hip_atomic_fetch_add(p, v, __ATOMIC_RELAXED, __HIP_MEMORY_SCOPE_AGENT); }
__device__ __forceinline__ unsigned xb_xcc_id() { return (unsigned)__builtin_amdgcn_s_getreg((3 << 11) | 20) & 0xFu; }
#define XB_SPIN(cond, bar) do { unsigned _sp = 0; while (cond) { __builtin_amdgcn_s_sleep(1); \
    if ((++_sp & 255u) == 0u) { if (xb_ld(&(bar)[XB_TMO])) break; if (_sp > XB_SPIN_CAP) { atomicAdd(&(bar)[XB_TMO], 1u); break; } } } } while (0)

struct XcdBarrier {
    unsigned* bar; unsigned x;
    volatile LAS unsigned* st;
};

__device__ __forceinline__ XcdBarrier xcd_barrier_post(unsigned* bar, volatile LAS unsigned* st) {
    XcdBarrier b; b.bar = bar; b.x = xb_xcc_id(); b.st = st;
    if (threadIdx.x == 0) (void)xb_add(&bar[XB_XCNT(b.x)], 1u);
    return b;
}
__device__ __forceinline__ void xcd_barrier_complete(unsigned* bar, unsigned x, unsigned& nloc, unsigned& nx) {
    const unsigned G = gridDim.x * gridDim.y * gridDim.z;
    unsigned sum, cnt, mine, sp = 0u;
    for (;;) {
        sum = 0u; cnt = 0u; mine = 0u;
#pragma unroll
        for (unsigned j = 0; j < 16; ++j) { const unsigned c = xb_ld(&bar[XB_XCNT(j)]); sum += c; cnt += (c > 0u) ? 1u : 0u; mine = (j == x) ? c : mine; }
        if (sum == G) break;
        __builtin_amdgcn_s_sleep(1);
        if ((++sp & 255u) == 0u) { if (xb_ld(&bar[XB_TMO])) break; if (sp > XB_SPIN_CAP) { atomicAdd(&bar[XB_TMO], 1u); break; } }
    }
    nloc = mine > 0u ? mine : 1u; nx = cnt > 0u ? cnt : 1u;
}

__device__ __forceinline__ void xcd_barrier(const XcdBarrier& b) {
    asm volatile("s_waitcnt vmcnt(0)" ::: "memory");
    __syncthreads();
    if (threadIdx.x == 0) {
        unsigned* bar = b.bar;
        __builtin_amdgcn_s_waitcnt(0);
        unsigned nloc = b.st[0], nx = b.st[1];
        if (nloc == 0u) { xcd_barrier_complete(bar, b.x, nloc, nx); b.st[0] = nloc; b.st[1] = nx; }
        const unsigned old = xb_add(&bar[XB_XSUB(b.x)], 1u);
        const unsigned gen = old / nloc;
        if (old + 1u == (gen + 1u) * nloc) {
            __builtin_amdgcn_fence(__ATOMIC_RELEASE, "agent");
            asm volatile("s_waitcnt vmcnt(0)" ::: "memory");
            const unsigned og = xb_add(&bar[XB_TOP], 1u);
            const unsigned tg = og / nx;
            if (og + 1u == (tg + 1u) * nx) xb_add(&bar[XB_TOPGEN], 1u);
            else XB_SPIN(xb_ld(&bar[XB_TOPGEN]) == tg, bar);
            __builtin_amdgcn_fence(__ATOMIC_ACQUIRE, "agent");
            xb_add(&bar[XB_XGEN(b.x)], 1u);
            asm volatile("s_waitcnt vmcnt(0)" ::: "memory");
        } else {
            XB_SPIN(xb_ld(&bar[XB_XGEN(b.x)]) == gen, bar);
            __builtin_amdgcn_fence(__ATOMIC_ACQUIRE, "agent");
            asm volatile("s_waitcnt vmcnt(0)" ::: "memory");
        }
    }
    __syncthreads();
}

constexpr int NWAVES = 8;
constexpr int DM = 2048, NB = 4, SEQ = 4096, DEPTH = 4, MTOK = NB * SEQ;
constexpr int DIN = 9216, FFH = 5632, NF13 = 2 * FFH, MODW = 6 * DM;
constexpr int PC_V = 1024, PC_G0 = 5120, PC_G1 = 7168;
constexpr float EPS = 1e-6f;
constexpr size_t MiB = 1u << 20;
constexpr size_t WS_CTL = 0, CTL_ZERO_BYTES = 1 * MiB;
constexpr size_t WS_MOD = 1 * MiB;
constexpr size_t WS_ROPE = 2 * MiB;
constexpr size_t WS_LAM = 3 * MiB;
constexpr size_t WS_WSB = 4 * MiB;
constexpr size_t WS_VSTAT = 5 * MiB;
constexpr size_t WS_WIN = 8 * MiB;
constexpr size_t WS_WUG = 152 * MiB;
constexpr size_t WS_WUA = 168 * MiB;
constexpr size_t WS_WO = 184 * MiB;
constexpr size_t WS_W13 = 216 * MiB;
constexpr size_t WS_W2 = 392 * MiB;
constexpr size_t WS_X = 480 * MiB;
constexpr size_t WS_H = 608 * MiB;
constexpr size_t WS_BRA = 672 * MiB;
constexpr size_t WS_BRB = 704 * MiB;
constexpr size_t WS_MG = 736 * MiB;
constexpr size_t WS_P = 800 * MiB;
constexpr size_t WS_END = 1088 * MiB;
constexpr int CW_TMO = 0, CW_CODE = 1, CW_BAR = 4096;
constexpr int RING_OFF = 0, RING_BYTES = 131072;
constexpr int LDSCTL_OFF = RING_BYTES, MISC_OFF = LDSCTL_OFF + 320;
constexpr int LDS_BYTES = 147456;

struct Frame {
    LAS unsigned char* lds;
    volatile LAS unsigned* MISC;
    gu32* ctl;
    int wave;
    int vcu, G;
};

__device__ __forceinline__ int fresh_tid() { int t = threadIdx.x; asm volatile("" : "+v"(t)); return t; }
__device__ __forceinline__ float wave_sum(float v) {
#pragma unroll
    for (int o = 1; o < 64; o <<= 1) v += __shfl_xor(v, o);
    return v;
}
__device__ __forceinline__ int dest_row(int n, int mode) {
    if (mode == 1) { if (n >= 2048 && n < 4096) { const int i = n & 63; return (n & ~63) + (i < 32 ? 2 * i : 2 * (i - 32) + 1); } return n; }
    if (mode == 2) return (n >> 7) * 256 + (n & 127);
    if (mode == 3) return (n >> 7) * 256 + 128 + (n & 127);
    return n;
}
__device__ __forceinline__ void p0_transpose_item(const float* W, int K, int N, bf16* WT, int mode, LAS float* scr, int item, int lane) {
    const int nblk = N / 32, kb = item / nblk, nb = item % nblk, k0 = 64 * kb, n0 = 32 * nb;
#pragma unroll 8
    for (int i = 0; i < 32; ++i) { const int kk = 2 * i + (lane >> 5); scr[kk * 33 + (lane & 31)] = W[(size_t)(k0 + kk) * N + n0 + (lane & 31)]; }
    LDS_WAIT(); asm volatile("" ::: "memory");
    const int c = lane & 7;
#pragma unroll
    for (int j = 0; j < 4; ++j) { const int n = (lane >> 3) + 8 * j; const LAS float* s = scr + (8 * c) * 33 + n;
        v4u o; o.x = pk2(s[0 * 33], s[1 * 33]); o.y = pk2(s[2 * 33], s[3 * 33]); o.z = pk2(s[4 * 33], s[5 * 33]); o.w = pk2(s[6 * 33], s[7 * 33]);
        *(GAS v4u*)(WT + (size_t)dest_row(n0 + n, mode) * K + k0 + 8 * c) = o; }
    LDS_WAIT(); asm volatile("" ::: "memory");
}

struct In {
    const float *x, *c, *ada_w, *ada_b, *norm1_g, *norm2_g, *w_in, *gmlp_ln_g, *gmlp_ln_b, *w_s, *b_s, *lq1, *lk1, *lq2, *lk2, *subln_g, *w_up_gmlp, *w_up_attn, *w_o, *ffn_w1, *ffn_w3, *ffn_w2, *final_g;
};
struct Args { In in; float* out; unsigned char* ws; };

__device__ __forceinline__ void p0_prologue(const Frame& F, const In& I, unsigned char* ws) {
    const int tid = fresh_tid(), lane = tid & 63;
    float* mod = (float*)(ws + WS_MOD);
    {
        LAS float* cact = (LAS float*)(F.lds + RING_OFF);
        LAS float* red = (LAS float*)(F.lds + RING_OFF + 32768);
        bool have = false;
        for (int it = F.vcu; it < DEPTH * (MODW / 256); it += F.G) {
            if (!have) { for (int i = tid; i < NB * DM; i += NWAVES * 64) { const float cv = I.c[i]; cact[i] = cv / (1.0f + expf(-cv)); } have = true; __syncthreads(); }
            const int l = it / (MODW / 256), s = it % (MODW / 256);
            const float* wp = I.ada_w + ((size_t)l * DM + F.wave * 256) * MODW + s * 256 + 4 * lane;
            f32x4 a0 = {0.f, 0.f, 0.f, 0.f}, a1 = a0, a2 = a0, a3 = a0;
            const LAS float* cp = cact + F.wave * 256;
#pragma unroll 8
            for (int kk = 0; kk < 256; ++kk) { const f32x4 w = *(const f32x4*)(wp + (size_t)kk * MODW);
                a0 += w * cp[kk]; a1 += w * cp[DM + kk]; a2 += w * cp[2 * DM + kk]; a3 += w * cp[3 * DM + kk]; }
            *(LAS f32x4*)(red + (F.wave * NB + 0) * 256 + 4 * lane) = a0; *(LAS f32x4*)(red + (F.wave * NB + 1) * 256 + 4 * lane) = a1;
            *(LAS f32x4*)(red + (F.wave * NB + 2) * 256 + 4 * lane) = a2; *(LAS f32x4*)(red + (F.wave * NB + 3) * 256 + 4 * lane) = a3;
            __syncthreads();
            for (int idx = tid; idx < NB * 256; idx += NWAVES * 64) { const int b = idx >> 8, col = idx & 255; float sum = I.ada_b[(size_t)l * MODW + s * 256 + col];
#pragma unroll
                for (int w = 0; w < 8; ++w) sum += red[(w * NB + b) * 256 + col];
                mod[((size_t)l * NB + b) * MODW + s * 256 + col] = sum; }
            __syncthreads();
        }
        __syncthreads();
    }
    const int gtid = F.vcu * (NWAVES * 64) + tid, NGT = F.G * NWAVES * 64;
    {
        float* rc = (float*)(ws + WS_ROPE); float* rs = rc + SEQ * 32;
        for (int idx = gtid; idx < SEQ * 32; idx += NGT) { const int pos = idx >> 5, i = idx & 31;
            const float invf = (float)exp2(-(double)i * (13.287712379549449 / 32.0));
            const float angf = (float)pos * invf; const double ang = (double)angf;
            const double kq = rint(ang * 0.63661977236758134); const double t = (ang - kq * 1.5707963267948966) - kq * 6.123233995736766e-17; const double t2 = t * t;
            const double sp = t * (1.0 + t2 * (-1.0 / 6 + t2 * (1.0 / 120 + t2 * (-1.0 / 5040 + t2 * (1.0 / 362880 + t2 * (-1.0 / 39916800))))));
            const double cp = 1.0 + t2 * (-0.5 + t2 * (1.0 / 24 + t2 * (-1.0 / 720 + t2 * (1.0 / 40320 + t2 * (-1.0 / 3628800 + t2 * (1.0 / 479001600))))));
            const int qd = ((int)kq) & 3; const double cv = qd == 0 ? cp : qd == 1 ? -sp : qd == 2 ? -cp : sp; const double sv = qd == 0 ? sp : qd == 1 ? cp : qd == 2 ? -sp : -cp;
            rc[idx] = (float)cv; rs[idx] = (float)sv; }
    }
    if (blockIdx.x == 0 && F.wave == 0) {
        for (int l = 0; l < DEPTH; ++l) { const float s1 = wave_sum(I.lq1[l * 64 + lane] * I.lk1[l * 64 + lane]), s2 = wave_sum(I.lq2[l * 64 + lane] * I.lk2[l * 64 + lane]);
            const float linit = 0.8f - 0.6f * expf(-0.3f * (float)l);
            if (lane == 0) ((float*)(ws + WS_LAM))[l] = expf(s1) - expf(s2) + linit; }
    }
    { bf16* wsb = (bf16*)(ws + WS_WSB);
        for (int i = gtid; i < DEPTH * 8 * 128 * 128 / 4; i += NGT) { const f32x4 v = *(const f32x4*)(I.w_s + (size_t)i * 4); unsigned long long o = (unsigned long long)pk2(v.x, v.y) | ((unsigned long long)pk2(v.z, v.w) << 32); *(GAS unsigned long long*)(wsb + (size_t)i * 4) = o; } }
    LAS float* scr = (LAS float*)(F.lds + RING_OFF + F.wave * 16384);
    const int gw = F.vcu * NWAVES + F.wave, NGW = F.G * NWAVES;
    constexpr int I_IN = (DM / 64) * (DIN / 32), I_UP = (1024 / 64) * (DM / 32), I_O = (DM / 64) * (DM / 32), I_F1 = (DM / 64) * (FFH / 32), I_F2 = (FFH / 64) * (DM / 32);
    constexpr int I_LAYER = I_IN + 2 * I_UP + I_O + 2 * I_F1 + I_F2;
    for (int it = gw; it < DEPTH * I_LAYER; it += NGW) {
        const int l = it / I_LAYER; int r = it % I_LAYER;
        if (r < I_IN) { p0_transpose_item(I.w_in + (size_t)l * DM * DIN, DM, DIN, (bf16*)(ws + WS_WIN) + (size_t)l * DIN * DM, 1, scr, r, lane); continue; } r -= I_IN;
        if (r < I_UP) { p0_transpose_item(I.w_up_gmlp + (size_t)l * 1024 * DM, 1024, DM, (bf16*)(ws + WS_WUG) + (size_t)l * DM * 1024, 0, scr, r, lane); continue; } r -= I_UP;
        if (r < I_UP) { p0_transpose_item(I.w_up_attn + (size_t)l * 1024 * DM, 1024, DM, (bf16*)(ws + WS_WUA) + (size_t)l * DM * 1024, 0, scr, r, lane); continue; } r -= I_UP;
        if (r < I_O) { p0_transpose_item(I.w_o + (size_t)l * DM * DM, DM, DM, (bf16*)(ws + WS_WO) + (size_t)l * DM * DM, 0, scr, r, lane); continue; } r -= I_O;
        if (r < I_F1) { p0_transpose_item(I.ffn_w1 + (size_t)l * DM * FFH, DM, FFH, (bf16*)(ws + WS_W13) + (size_t)l * NF13 * DM, 2, scr, r, lane); continue; } r -= I_F1;
        if (r < I_F1) { p0_transpose_item(I.ffn_w3 + (size_t)l * DM * FFH, DM, FFH, (bf16*)(ws + WS_W13) + (size_t)l * NF13 * DM, 3, scr, r, lane); continue; } r -= I_F1;
        p0_transpose_item(I.ffn_w2 + (size_t)l * FFH * DM, FFH, DM, (bf16*)(ws + WS_W2) + (size_t)l * DM * FFH, 0, scr, r, lane);
    }
}

__device__ __forceinline__ void norm_mod_phase(const Frame& F0, const float* x, const float* g, const float* sh, const float* sc, bf16* H) {
    const Frame& F = F0; const int lane = fresh_tid() & 63;
    const int gw = F.vcu * NWAVES + F.wave, NGW = F.G * NWAVES;
    for (int r0 = gw * 8; r0 < MTOK; r0 += NGW * 8) {
        const int b = r0 / SEQ; const float* shb = sh + (size_t)b * MODW + 4 * lane; const float* scb = sc + (size_t)b * MODW + 4 * lane;
        f32x4 cf[8], sv[8];
#pragma unroll
        for (int j = 0; j < 8; ++j) { const f32x4 g4 = *(const f32x4*)(g + 256 * j + 4 * lane), s4 = *(const f32x4*)(scb + 256 * j); cf[j] = g4 * (1.0f + s4); sv[j] = *(const f32x4*)(shb + 256 * j); }
#pragma unroll 2
        for (int i = 0; i < 8; ++i) {
            const GAS f32x4* xr = (const GAS f32x4*)(x + (size_t)(r0 + i) * DM) + lane;
            f32x4 v[8]; float ss = 0.f;
#pragma unroll
            for (int j = 0; j < 8; ++j) { v[j] = xr[64 * j]; ss += (v[j].x * v[j].x + v[j].y * v[j].y) + (v[j].z * v[j].z + v[j].w * v[j].w); }
            const float r = 1.0f / sqrtf(wave_sum(ss) * (1.0f / DM) + EPS);
            GAS unsigned long long* o8 = (GAS unsigned long long*)(H + (size_t)(r0 + i) * DM) + lane;
#pragma unroll
            for (int j = 0; j < 8; ++j) { const f32x4 y = v[j] * r * cf[j] + sv[j]; o8[64 * j] = (unsigned long long)pk2(y.x, y.y) | ((unsigned long long)pk2(y.z, y.w) << 32); }
        }
    }
}
__device__ __forceinline__ void final_norm_phase(const Frame& F, const float* x, const float* g, float* out, bool poison) {
    const int lane = fresh_tid() & 63;
    const int gw = F.vcu * NWAVES + F.wave, NGW = F.G * NWAVES; const float qn = __builtin_nanf("");
    f32x4 gv[8];
#pragma unroll
    for (int j = 0; j < 8; ++j) gv[j] = *(const f32x4*)(g + 256 * j + 4 * lane);
    for (int row = gw; row < MTOK; row += NGW) {
        const GAS f32x4* xr = (const GAS f32x4*)(x + (size_t)row * DM) + lane;
        f32x4 v[8]; float ss = 0.f;
#pragma unroll
        for (int j = 0; j < 8; ++j) { v[j] = xr[64 * j]; ss += (v[j].x * v[j].x + v[j].y * v[j].y) + (v[j].z * v[j].z + v[j].w * v[j].w); }
        const float r = 1.0f / sqrtf(wave_sum(ss) * (1.0f / DM) + EPS);
        GAS f32x4* o = (GAS f32x4*)(out + (size_t)row * DM) + lane;
#pragma unroll
        for (int j = 0; j < 8; ++j) { f32x4 y = v[j] * r * gv[j]; if (poison) y = (f32x4){qn, qn, qn, qn}; o[64 * j] = y; }
    }
}

__global__ void __launch_bounds__(NWAVES * 64, 2) mk_fwd(Args args) {
    extern __shared__ __attribute__((aligned(16))) unsigned char lds[];
    Frame F;
    F.lds = (LAS unsigned char*)lds;
    F.MISC = (volatile LAS unsigned*)(F.lds + MISC_OFF);
    F.wave = __builtin_amdgcn_readfirstlane(threadIdx.x >> 6);
    F.G = gridDim.x; { const int bx = blockIdx.x; F.vcu = (F.G % 8 == 0) ? (bx % 8) * (F.G / 8) + bx / 8 : bx; }
    unsigned char* ws = args.ws; const In& I = args.in;
    F.ctl = (gu32*)(ws + WS_CTL);
    for (int u = threadIdx.x; u < (LDS_BYTES - LDSCTL_OFF) / 4; u += NWAVES * 64) ((LAS unsigned*)(F.lds + LDSCTL_OFF))[u] = 0u;
    __syncthreads();
    XcdBarrier bar = xcd_barrier_post((unsigned*)(F.ctl + CW_BAR), F.MISC + 8);
#define GRID_BAR() do { XcdBarrier b2_ = bar; asm volatile("" : "+s"(b2_.bar), "+s"(b2_.x)); xcd_barrier(b2_); } while (0)

    float* const mod = (float*)(ws + WS_MOD);
    const float* const rcos = (const float*)(ws + WS_ROPE); const float* const rsin = rcos + SEQ * 32;
    float* const X = (float*)(ws + WS_X);
    bf16* const H = (bf16*)(ws + WS_H); bf16* const BRA = (bf16*)(ws + WS_BRA); bf16* const BRB = (bf16*)(ws + WS_BRB); bf16* const MG = (bf16*)(ws + WS_MG);
    bf16* const P = (bf16*)(ws + WS_P); bf16* const T = (bf16*)(ws + WS_P);
    pg8::f32x2* const vstat = (pg8::f32x2*)(ws + WS_VSTAT);

#ifndef PHM
#define PHM 0xFFFFF
#endif
    if constexpr (PHM & 1) p0_prologue(F, I, ws);
    GRID_BAR();

    for (int l = 0; l < DEPTH; ++l) {
        const float* modl = mod + (size_t)l * NB * MODW;
        const float* xin = (l == 0) ? I.x : X;
        if constexpr (PHM & 2) norm_mod_phase(F, xin, I.norm1_g + (size_t)l * DM, modl + 0 * DM, modl + 1 * DM, H);
        GRID_BAR();
        if constexpr (PHM & 4) { pg8::Gemm g{H, (const bf16*)(ws + WS_WIN) + (size_t)l * DIN * DM, MTOK, DIN, DM}; pg8::StaticOrder S; S.init(MTOK, DIN, F.G, (int)blockIdx.x);
          pg8::EpiIn E{P, rcos, rsin, vstat};
          pg8::gemm_phase<pg8::EpiIn, pg8::StaticOrder, true, true>(F.lds + RING_OFF, g, S, E); }
        GRID_BAR();
        if constexpr (PHM & 8) { const float lam = ((const float*)(ws + WS_LAM))[l]; const float oml = 1.0f - (0.8f - 0.6f * expf(-0.3f * (float)l));
          if constexpr (PHM & 0x1000) for (int u = F.vcu; u < NB * 8 * (SEQ / 128); u += F.G) { const int bh = u >> 5, qb = u & 31;
              att::attn_unit(P, BRB, bh >> 3, bh & 7, qb, lam, oml, I.subln_g + (size_t)l * 128, (LAS char*)(F.lds + RING_OFF)); }
          if constexpr (PHM & 0x2000) for (int u = F.vcu; u < NB * (SEQ / 128) * 8; u += F.G) { const int g = u & 7, bn = u >> 3;
              att::gmlp_unit(P, BRA, (const att::f32x2v*)vstat, (const bf16*)(ws + WS_WSB) + (size_t)l * 8 * 128 * 128, I.b_s + (size_t)l * 8 * 128, I.gmlp_ln_g + (size_t)l * 1024, I.gmlp_ln_b + (size_t)l * 1024,
                             bn >> 5, bn & 31, g, (LAS char*)(F.lds + RING_OFF)); } }
        GRID_BAR();
        if constexpr (PHM & 16) { pg8::Gemm g{BRA, (const bf16*)(ws + WS_WUG) + (size_t)l * DM * 1024, MTOK, DM, 1024}; pg8::StaticOrder S; S.init(MTOK, DM, F.G, (int)blockIdx.x);
          pg8::EpiUp<0> E{MG, P, PC_G0};
          pg8::gemm_phase<pg8::EpiUp<0>, pg8::StaticOrder, true, true>(F.lds + RING_OFF, g, S, E); }
        if constexpr (PHM & 32) { pg8::Gemm g{BRB, (const bf16*)(ws + WS_WUA) + (size_t)l * DM * 1024, MTOK, DM, 1024}; pg8::StaticOrder S; S.init(MTOK, DM, F.G, (int)blockIdx.x);
          pg8::EpiUp<1> E{MG, P, PC_G1};
          pg8::gemm_phase<pg8::EpiUp<1>, pg8::StaticOrder, true, true>(F.lds + RING_OFF, g, S, E); }
        GRID_BAR();
        if constexpr (PHM & 64) { pg8::Gemm g{MG, (const bf16*)(ws + WS_WO) + (size_t)l * DM * DM, MTOK, DM, DM}; pg8::StaticOrder S; S.init(MTOK, DM, F.G, (int)blockIdx.x);
          pg8::EpiRes E{xin, X, modl + 2 * DM, MODW};
          pg8::gemm_phase<pg8::EpiRes, pg8::StaticOrder, true, true>(F.lds + RING_OFF, g, S, E); }
        GRID_BAR();
        if constexpr (PHM & 128) norm_mod_phase(F, X, I.norm2_g + (size_t)l * DM, modl + 3 * DM, modl + 4 * DM, H);
        GRID_BAR();
        if constexpr (PHM & 256) { pg8::Gemm g{H, (const bf16*)(ws + WS_W13) + (size_t)l * NF13 * DM, MTOK, NF13, DM}; pg8::StaticOrder S; S.init(MTOK, NF13, F.G, (int)blockIdx.x);
          pg8::EpiSwiglu E{T};
          pg8::gemm_phase<pg8::EpiSwiglu, pg8::StaticOrder, true, true>(F.lds + RING_OFF, g, S, E); }
        GRID_BAR();
        if constexpr (PHM & 512) { pg8::Gemm g{T, (const bf16*)(ws + WS_W2) + (size_t)l * DM * FFH, MTOK, DM, FFH}; pg8::StaticOrder S; S.init(MTOK, DM, F.G, (int)blockIdx.x);
          pg8::EpiRes E{X, X, modl + 5 * DM, MODW};
          pg8::gemm_phase<pg8::EpiRes, pg8::StaticOrder, true, true>(F.lds + RING_OFF, g, S, E); }
        GRID_BAR();
    }
    { const bool poison = (__hip_atomic_load((gu32*)((unsigned*)(F.ctl + CW_BAR) + XB_TMO), RLX_AGENT) != 0u) || (__hip_atomic_load(F.ctl + CW_TMO, RLX_AGENT) != 0u);
      final_norm_phase(F, X, I.final_g, args.out, poison); }
#undef GRID_BAR
}

extern "C" void kernel_launch(void* const* d_in, const int* in_sizes, int n_in, void* d_out, int out_size, void* d_ws, size_t ws_size, hipStream_t stream) {
    static int grid = 0;
    if (grid == 0) {
        if (n_in != 23 || in_sizes[0] != MTOK * DM || out_size != MTOK * DM || ws_size < WS_END) { fprintf(stderr, "kernel_launch: unexpected shapes: n_in %d in0 %d out %d ws %zu (need %zu)\n", n_in, n_in > 0 ? in_sizes[0] : -1, out_size, ws_size, (size_t)WS_END); grid = -1; return; }
        int dev = 0, cus = 0, per_cu = 0;
        if (hipGetDevice(&dev) != hipSuccess || hipDeviceGetAttribute(&cus, hipDeviceAttributeMultiprocessorCount, dev) != hipSuccess) { fprintf(stderr, "kernel_launch: device query failed\n"); grid = -1; return; }
        if (hipFuncSetAttribute((const void*)mk_fwd, hipFuncAttributeMaxDynamicSharedMemorySize, LDS_BYTES) != hipSuccess) { fprintf(stderr, "kernel_launch: hipFuncSetAttribute failed\n"); grid = -1; return; }
        if (hipOccupancyMaxActiveBlocksPerMultiprocessor(&per_cu, (const void*)mk_fwd, NWAVES * 64, LDS_BYTES) != hipSuccess || per_cu < 1) { fprintf(stderr, "kernel_launch: occupancy query reports %d blocks per CU\n", per_cu); }
        (void)hipGetLastError();
        grid = cus;
    }
    if (grid < 0) return;
    if (hipMemsetAsync((char*)d_ws + WS_CTL, 0, CTL_ZERO_BYTES, stream) != hipSuccess) { fprintf(stderr, "kernel_launch: memset failed\n"); return; }
    Args a{};
    const float** ip = (const float**)&a.in;
    for (int i = 0; i < 23; ++i) ip[i] = (const float*)d_in[i];
    a.out = (float*)d_out; a.ws = (unsigned char*)d_ws;
    hipLaunchKernelGGL(mk_fwd, dim3(grid), dim3(NWAVES * 64), LDS_BYTES, stream, a);
    const hipError_t le = hipPeekAtLastError();
    if (le != hipSuccess) fprintf(stderr, "kernel_launch: launch failed: %s\n", hipGetErrorName(le));
}
```

```cpp
#include <hip/hip_runtime.h>
#include <hip/hip_bf16.h>
#include <cstdio>
#include <cstdint>
#include <cmath>
#ifdef PROBE_MASK
#define ATT_STAMP_BASE 151552
#define ATT_STAMP0() do { if (blockIdx.x == 0 && threadIdx.x == 0) ((__attribute__((address_space(3))) unsigned*)((__attribute__((address_space(3))) char*)lds + ATT_STAMP_BASE))[31] = (unsigned)__builtin_amdgcn_s_memrealtime(); } while (0)
#define ATT_STAMP(p) do { if (blockIdx.x == 0 && threadIdx.x == 0) { __attribute__((address_space(3))) unsigned* w__ = (__attribute__((address_space(3))) unsigned*)((__attribute__((address_space(3))) char*)lds + ATT_STAMP_BASE); const unsigned t__ = (unsigned)__builtin_amdgcn_s_memrealtime(); w__[p] += t__ - w__[31]; w__[31] = t__; } } while (0)
#else
#define ATT_STAMP0() do { } while (0)
#define ATT_STAMP(p) do { } while (0)
#endif
namespace pg8 {
#define PG8_LAS __attribute__((address_space(3)))
typedef unsigned short bf16_t;
typedef short bf16x8 __attribute__((ext_vector_type(8)));
typedef float f32x4 __attribute__((ext_vector_type(4)));
typedef unsigned u32x4 __attribute__((ext_vector_type(4)));
constexpr int BM = 256, BK = 64, HALF = 128, HTB = HALF * BK * 2  , STAGE_BYTES = 8 * HTB, NXCD = 8, WGM = 8;

__host__ __device__ __forceinline__ int lds_byte(int r, int c) { const int st = (r >> 4) * 2 + (c >> 5), rr = r & 15, cc = c & 31, ob = rr * 64 + cc * 2; return st * 1024 + (ob ^ (((ob >> 9) & 1) << 5)); }
__host__ __device__ __forceinline__ void stage_rc(int b, int& R, int& C) { const int st = b / 1024, sb = b % 1024, swz = sb ^ (((sb >> 9) & 1) << 5); R = (st >> 1) * 16 + swz / 64; C = (st & 1) * 32 + (swz % 64) / 2; }
__host__ __device__ __forceinline__ int perm32(int rho) { const int n = rho >> 4, i = rho & 15; return 8 * (i >> 2) + 4 * n + (i & 3); }

struct Unit { int pm, pn; };
struct Gemm { const bf16_t* A; const bf16_t* Bt; int M, N, K; };

struct StaticOrder {
    int nM, nN, nwg, G, c;
    __host__ __device__ void init(int M, int N, int G_, int c_) { nM = M / BM; nN = N / BM; nwg = nM * nN; G = G_; c = c_; }
    __host__ __device__ bool next(int i, Unit& u) const {
        const long L = (long)i * G + c; if (L >= nwg) return false;
        int wgid = (int)L; { const int q = nwg / NXCD, r = nwg % NXCD, xcd = wgid % NXCD, off = wgid / NXCD; wgid = (xcd < r ? xcd * (q + 1) : r * (q + 1) + (xcd - r) * q) + off; }
        const int nig = WGM * nN, gid = wgid / nig, fm = gid * WGM, gsz = (nM - fm) < WGM ? (nM - fm) : WGM;
        u.pm = fm + ((wgid % nig) % gsz); u.pn = (wgid % nig) / gsz; return true;
    }
    __device__ __forceinline__ void a_ready(const Unit&) const {}
    __device__ __forceinline__ void done(const Unit&) const {}
};

struct UvOrder : StaticOrder {
    unsigned* cnt;
    __device__ __forceinline__ void done(const Unit& u) const {
        if (u.pn < 8) { asm volatile("s_waitcnt vmcnt(0)" ::: "memory");
            if (__builtin_amdgcn_mbcnt_hi(~0u, __builtin_amdgcn_mbcnt_lo(~0u, 0u)) == 0u) (void)__hip_atomic_fetch_add(cnt + 64 * u.pm, 1u, __ATOMIC_RELAXED, __HIP_MEMORY_SCOPE_AGENT); }
    }
};

__device__ __forceinline__ unsigned cvt_pk_bf16(float lo, float hi) { unsigned r; asm volatile("v_cvt_pk_bf16_f32 %0, %1, %2" : "=v"(r) : "v"(lo), "v"(hi)); return r; }
typedef float f32x2 __attribute__((ext_vector_type(2)));
typedef unsigned u32x2 __attribute__((ext_vector_type(2)));
__device__ __forceinline__ float bf_lo(unsigned w) { return __uint_as_float(w << 16); }
__device__ __forceinline__ float bf_hi(unsigned w) { return __uint_as_float(w & 0xffff0000u); }
__device__ __forceinline__ float sigmoid_f(float x) { return __builtin_amdgcn_rcpf(1.0f + __builtin_amdgcn_exp2f(x * -1.4426950408889634f)); }
__device__ __forceinline__ float gelu_tanh_f(float x) { const float z = x * (1.5957691216057308f + 0.07135481627f * x * x); return x * sigmoid_f(z); }
__device__ __forceinline__ float silu_f(float x) { return x * sigmoid_f(x); }

#define ST16_WT(ptr, val) asm volatile("global_store_dwordx4 %0, %1, off sc1\n\ts_nop 1" :: "v"(ptr), "v"(val) : "memory")
#define ST8_WT(ptr, val)  asm volatile("global_store_dwordx2 %0, %1, off sc1\n\ts_nop 1" :: "v"(ptr), "v"(val) : "memory")
struct EpiIn {
    static constexpr bool PERM = true, AFTER_DRAIN = false, MIDK = false;
    bf16_t* P; bf16_t* QKV; const float* rcos; const float* rsin; f32x2* vstat;
    __device__ __forceinline__ void operator()(const f32x4 (&acc)[2][2][4][2], const Unit& u, int wr, int wc, int fr, int fq) const {
        const int pn = u.pn; const int row0 = u.pm * BM + wr * 64 + fr; const int colw = pn * BM + wc * 32 + 8 * fq;
        if (pn < 8) {
#pragma unroll
            for (int ai = 0; ai < 2; ++ai)
#pragma unroll
                for (int m = 0; m < 4; ++m) { const int row = row0 + ai * HALF + m * 16; bf16_t* rowp = P + (size_t)row * 9216 + colw;
                    float g[2][8];
#pragma unroll
                    for (int bj = 0; bj < 2; ++bj) {
#pragma unroll
                        for (int i = 0; i < 4; ++i) { g[bj][i] = gelu_tanh_f(acc[ai][bj][m][0][i]); g[bj][4 + i] = gelu_tanh_f(acc[ai][bj][m][1][i]); }
                        u32x4 w; w.x = cvt_pk_bf16(g[bj][0], g[bj][1]); w.y = cvt_pk_bf16(g[bj][2], g[bj][3]); w.z = cvt_pk_bf16(g[bj][4], g[bj][5]); w.w = cvt_pk_bf16(g[bj][6], g[bj][7]);
                        ST16_WT(rowp + bj * HALF, w); }
                    if (pn >= 4) {
                        float s = 0.f;
#pragma unroll
                        for (int bj = 0; bj < 2; ++bj)
#pragma unroll
                            for (int i = 0; i < 8; ++i) s += g[bj][i];
                        s += __shfl_xor(s, 16); s += __shfl_xor(s, 32);
                        const float mw = s * (1.0f / 64.0f); float q = 0.f;
#pragma unroll
                        for (int bj = 0; bj < 2; ++bj)
#pragma unroll
                            for (int i = 0; i < 8; ++i) { const float d = g[bj][i] - mw; q += d * d; }
                        q += __shfl_xor(q, 16); q += __shfl_xor(q, 32);
                        if (fq == 0) { const f32x2 st_ = {mw, q}; ST8_WT(&vstat[(size_t)row * 16 + (pn - 4) * 4 + wc], st_); }
                    } }
        } else if (pn < 16) {
#pragma unroll
            for (int ai = 0; ai < 2; ++ai)
#pragma unroll
                for (int m = 0; m < 4; ++m) { const int row = row0 + ai * HALF + m * 16; const int pos = row & 4095;
                    bf16_t* rowp = QKV + ((size_t)((pn - 8) >> 2) * 32 + (size_t)(row >> 12) * 8 + (size_t)((pn & 3) * 2)) * (4096 * 128) + (size_t)pos * 128 + wc * 32 + 8 * fq;
#pragma unroll
                    for (int bj = 0; bj < 2; ++bj) { const int pr0 = ((colw + bj * HALF) & 63) >> 1;
                        const f32x4 cs = *(const f32x4*)(rcos + pos * 32 + pr0), sn = *(const f32x4*)(rsin + pos * 32 + pr0);
                        const float qs = (pn < 12) ? 0.18033688011112042f : 1.0f;
                        const f32x4 v0 = acc[ai][bj][m][0] * qs, v1 = acc[ai][bj][m][1] * qs;
                        u32x4 w;
                        w.x = cvt_pk_bf16(v0[0] * cs[0] - v0[1] * sn[0], v0[1] * cs[0] + v0[0] * sn[0]);
                        w.y = cvt_pk_bf16(v0[2] * cs[1] - v0[3] * sn[1], v0[3] * cs[1] + v0[2] * sn[1]);
                        w.z = cvt_pk_bf16(v1[0] * cs[2] - v1[1] * sn[2], v1[1] * cs[2] + v1[0] * sn[2]);
                        w.w = cvt_pk_bf16(v1[2] * cs[3] - v1[3] * sn[3], v1[3] * cs[3] + v1[2] * sn[3]);
                        *(u32x4*)(rowp + (size_t)bj * (4096 * 128)) = w; } }
        } else if (pn < 20) {
#pragma unroll
            for (int ai = 0; ai < 2; ++ai)
#pragma unroll
                for (int m = 0; m < 4; ++m) { const int row = row0 + ai * HALF + m * 16;
                    bf16_t* rowp = QKV + ((size_t)64 + (size_t)(row >> 12) * 8 + (size_t)((pn & 3) * 2)) * (4096 * 128) + (size_t)(row & 4095) * 128 + wc * 32 + 8 * fq;
#pragma unroll
                    for (int bj = 0; bj < 2; ++bj) { const f32x4 v0 = acc[ai][bj][m][0], v1 = acc[ai][bj][m][1];
                        u32x4 w; w.x = cvt_pk_bf16(v0[0], v0[1]); w.y = cvt_pk_bf16(v0[2], v0[3]); w.z = cvt_pk_bf16(v1[0], v1[1]); w.w = cvt_pk_bf16(v1[2], v1[3]);
                        *(u32x4*)(rowp + (size_t)bj * (4096 * 128)) = w; } }
        } else {
            const int cg = (pn - 20) * HALF + wc * 32 + 8 * fq;
#pragma unroll
            for (int ai = 0; ai < 2; ++ai)
#pragma unroll
                for (int m = 0; m < 4; ++m) { bf16_t* rowp = P + (size_t)(row0 + ai * HALF + m * 16) * 9216 + cg;
                    float rr[8], g1[8];
#pragma unroll
                    for (int i = 0; i < 4; ++i) {
                        const float e0a = __builtin_amdgcn_exp2f(acc[ai][0][m][0][i] * -1.4426950408889634f), e1a = __builtin_amdgcn_exp2f(acc[ai][1][m][0][i] * -1.4426950408889634f);
                        const float e0b = __builtin_amdgcn_exp2f(acc[ai][0][m][1][i] * -1.4426950408889634f), e1b = __builtin_amdgcn_exp2f(acc[ai][1][m][1][i] * -1.4426950408889634f);
                        g1[i] = __builtin_amdgcn_rcpf(1.0f + e1a); rr[i] = (1.0f + e1a) * __builtin_amdgcn_rcpf(1.0f + e0a);
                        g1[4 + i] = __builtin_amdgcn_rcpf(1.0f + e1b); rr[4 + i] = (1.0f + e1b) * __builtin_amdgcn_rcpf(1.0f + e0b); }
                    u32x4 w; w.x = cvt_pk_bf16(rr[0], rr[1]); w.y = cvt_pk_bf16(rr[2], rr[3]); w.z = cvt_pk_bf16(rr[4], rr[5]); w.w = cvt_pk_bf16(rr[6], rr[7]);
                    *(u32x4*)(rowp + 5120) = w;
                    w.x = cvt_pk_bf16(g1[0], g1[1]); w.y = cvt_pk_bf16(g1[2], g1[3]); w.z = cvt_pk_bf16(g1[4], g1[5]); w.w = cvt_pk_bf16(g1[6], g1[7]);
                    *(u32x4*)(rowp + 7168) = w; }
        }
    }
};

struct EpiUpCat {
    static constexpr bool PERM = true, AFTER_DRAIN = false, MIDK = true;
    bf16_t* MG; const bf16_t* P; int gcol0, gcol1;
    __device__ __forceinline__ void mid(f32x4 (&acc)[2][2][4][2], const Unit& u, int wr, int wc, int fr, int fq) const {
        int row0 = u.pm * BM + wr * 64 + fr; const int colw = u.pn * BM + wc * 32 + 8 * fq;
        asm volatile("" : "+v"(row0));
#pragma unroll
        for (int ai = 0; ai < 2; ++ai) {
            u32x4 ga[4][2];
#pragma unroll
            for (int m = 0; m < 4; ++m) { const bf16_t* grow = P + (size_t)(row0 + ai * HALF + m * 16) * 9216 + gcol0 + colw;
#pragma unroll
                for (int bj = 0; bj < 2; ++bj) ga[m][bj] = *(const u32x4*)(grow + bj * HALF); }
#pragma unroll
            for (int m = 0; m < 4; ++m)
#pragma unroll
                for (int bj = 0; bj < 2; ++bj) { const u32x4 a = ga[m][bj];
                    acc[ai][bj][m][0] *= (f32x4){bf_lo(a.x), bf_hi(a.x), bf_lo(a.y), bf_hi(a.y)}; acc[ai][bj][m][1] *= (f32x4){bf_lo(a.z), bf_hi(a.z), bf_lo(a.w), bf_hi(a.w)}; }
            asm volatile("" ::: "memory");
        }
    }
    __device__ __forceinline__ void operator()(const f32x4 (&acc)[2][2][4][2], const Unit& u, int wr, int wc, int fr, int fq) const {
        const int row0 = u.pm * BM + wr * 64 + fr; const int colw = u.pn * BM + wc * 32 + 8 * fq;
#pragma unroll
        for (int ai = 0; ai < 2; ++ai)
#pragma unroll
            for (int m = 0; m < 4; ++m) { const int row = row0 + ai * HALF + m * 16; bf16_t* mrow = MG + (size_t)row * 2048 + colw; const bf16_t* grow = P + (size_t)row * 9216 + gcol1 + colw;
#pragma unroll
                for (int bj = 0; bj < 2; ++bj) { const u32x4 gw = *(const u32x4*)(grow + bj * HALF);
                    const f32x4 v0 = acc[ai][bj][m][0], v1 = acc[ai][bj][m][1];
                    u32x4 w; w.x = cvt_pk_bf16(v0[0] * bf_lo(gw.x), v0[1] * bf_hi(gw.x)); w.y = cvt_pk_bf16(v0[2] * bf_lo(gw.y), v0[3] * bf_hi(gw.y));
                    w.z = cvt_pk_bf16(v1[0] * bf_lo(gw.z), v1[1] * bf_hi(gw.z)); w.w = cvt_pk_bf16(v1[2] * bf_lo(gw.w), v1[3] * bf_hi(gw.w));
                    *(u32x4*)(mrow + bj * HALF) = w; } }
    }
};

struct EpiDelta {
    static constexpr bool PERM = true, AFTER_DRAIN = false, MIDK = false;
    bf16_t* D; const float* gate; int gstride;
    __device__ __forceinline__ void operator()(const f32x4 (&acc)[2][2][4][2], const Unit& u, int wr, int wc, int fr, int fq) const {
        const int row0 = u.pm * BM + wr * 64 + fr; const int colw = u.pn * BM + wc * 32 + 8 * fq;
        const float* gb = gate + (size_t)((u.pm * BM) >> 12) * gstride + colw;
        f32x4 gv[2][2];
#pragma unroll
        for (int bj = 0; bj < 2; ++bj)
#pragma unroll
            for (int n = 0; n < 2; ++n) gv[bj][n] = *(const f32x4*)(gb + bj * HALF + n * 4);
#pragma unroll
        for (int ai = 0; ai < 2; ++ai)
#pragma unroll
            for (int m = 0; m < 4; ++m) { bf16_t* rowp = D + (size_t)(row0 + ai * HALF + m * 16) * 2048 + colw;
#pragma unroll
                for (int bj = 0; bj < 2; ++bj) { const f32x4 v0 = gv[bj][0] * acc[ai][bj][m][0], v1 = gv[bj][1] * acc[ai][bj][m][1];
                    u32x4 w; w.x = cvt_pk_bf16(v0[0], v0[1]); w.y = cvt_pk_bf16(v0[2], v0[3]); w.z = cvt_pk_bf16(v1[0], v1[1]); w.w = cvt_pk_bf16(v1[2], v1[3]);
                    *(u32x4*)(rowp + bj * HALF) = w; } }
    }
};

struct EpiSwiglu {
    static constexpr bool PERM = true, AFTER_DRAIN = false, MIDK = false;
    bf16_t* T;
    __device__ __forceinline__ void operator()(const f32x4 (&acc)[2][2][4][2], const Unit& u, int wr, int wc, int fr, int fq) const {
        const int row0 = u.pm * BM + wr * 64 + fr; const int colw = u.pn * HALF + wc * 32 + 8 * fq;
#pragma unroll
        for (int ai = 0; ai < 2; ++ai)
#pragma unroll
            for (int m = 0; m < 4; ++m) { bf16_t* rowp = T + (size_t)(row0 + ai * HALF + m * 16) * 5632 + colw;
                const f32x4 a0 = acc[ai][0][m][0], a1 = acc[ai][0][m][1], b0 = acc[ai][1][m][0], b1 = acc[ai][1][m][1];
                u32x4 w; w.x = cvt_pk_bf16(silu_f(a0[0]) * b0[0], silu_f(a0[1]) * b0[1]); w.y = cvt_pk_bf16(silu_f(a0[2]) * b0[2], silu_f(a0[3]) * b0[3]);
                w.z = cvt_pk_bf16(silu_f(a1[0]) * b1[0], silu_f(a1[1]) * b1[1]); w.w = cvt_pk_bf16(silu_f(a1[2]) * b1[2], silu_f(a1[3]) * b1[3]);
                *(u32x4*)rowp = w; }
    }
};
template <class Epi, class Sched, bool ALIGN_EPI = false, bool SP2 = false>
__device__ __forceinline__ void gemm_phase(PG8_LAS unsigned char* lds, const Gemm g, const Sched& S, const Epi& E) {
    int tid_ = threadIdx.x; asm volatile("" : "+v"(tid_));
    const int tid = tid_, wid = __builtin_amdgcn_readfirstlane(tid >> 6), lane = tid & 63, wr = wid >> 2, wc = wid & 3, fr = lane & 15, fq = lane >> 4;
    const int K = g.K, nt = K / BK;
    unsigned voffA[2], voffB[2];
#pragma unroll
    for (int i = 0; i < 2; ++i) { int R, C; stage_rc(tid * 16 + i * 8192, R, C); const int Rb = Epi::PERM ? ((R & ~31) + perm32(R & 31)) : R;
        voffA[i] = (unsigned)(R * K + C) * 2u; voffB[i] = (unsigned)(Rb * K + C) * 2u; }
    const size_t kstep = (size_t)(BK * 2);
    const size_t hstep = (size_t)HALF * K * 2;
    const size_t tstep = 2 * hstep;
    const unsigned ldsw = (unsigned)wid * 1024u;
    const int aoff = lds_byte(wr * 64 + fr, fq * 8), boff = lds_byte(wc * 32 + fr, fq * 8);
#define PG8_SA(b, h) (((b) * 2 + (h)) * HTB)
#define PG8_SB(b, h) ((4 + (b) * 2 + (h)) * HTB)
#define PG8_STAGE(bufoff, gbase, voff) do { _Pragma("unroll") for (int _i = 0; _i < 2; ++_i) \
        __builtin_amdgcn_global_load_lds((const unsigned*)((const char*)(gbase) + (voff)[_i]), (PG8_LAS unsigned*)(lds + (bufoff) + ldsw + _i * 8192), 16, 0, 0); } while (0)
#define PG8_LDA(dst, b, h) do { _Pragma("unroll") for (int m = 0; m < 4; ++m) _Pragma("unroll") for (int k = 0; k < 2; ++k) dst[m][k] = *(const PG8_LAS bf16x8*)(lds + PG8_SA(b, h) + aoff + m * 2048 + k * 1024); } while (0)
#define PG8_LDB(dst, b, h) do { _Pragma("unroll") for (int n = 0; n < 2; ++n) _Pragma("unroll") for (int k = 0; k < 2; ++k) dst[n][k] = *(const PG8_LAS bf16x8*)(lds + PG8_SB(b, h) + boff + n * 2048 + k * 1024); } while (0)
#define PG8_MMA(ai, bj, At, Bt) do { __builtin_amdgcn_s_setprio(1); _Pragma("unroll") for (int m = 0; m < 4; ++m) _Pragma("unroll") for (int n = 0; n < 2; ++n) _Pragma("unroll") for (int k = 0; k < 2; ++k) \
        acc[ai][bj][m][n] = __builtin_amdgcn_mfma_f32_16x16x32_bf16(Bt[n][k], At[m][k], acc[ai][bj][m][n], 0, 0, 0); __builtin_amdgcn_s_setprio(0); } while (0)
#define PG8_WAIT_V(n) asm volatile("s_waitcnt vmcnt(" #n ")" ::: "memory")
#define PG8_WAIT_L(n) asm volatile("s_waitcnt lgkmcnt(" #n ")" ::: "memory")
#define PG8_BAR __builtin_amdgcn_s_barrier()
#define PG8_SCHED __builtin_amdgcn_sched_barrier(0)
    Unit cur, nxt; int ui = 0;
    if (!S.next(0, cur)) return;
    f32x4 acc[2][2][4][2];
#pragma unroll
    for (int a = 0; a < 2; ++a)
#pragma unroll
        for (int b = 0; b < 2; ++b)
#pragma unroll
            for (int m = 0; m < 4; ++m)
#pragma unroll
                for (int n = 0; n < 2; ++n) acc[a][b][m][n] = (f32x4){0.f, 0.f, 0.f, 0.f};
    bf16x8 At[4][2], B0[2][2], B1[2][2];
    const char* cA = (const char*)g.A + (size_t)cur.pm * tstep; const char* cB = (const char*)g.Bt + (size_t)cur.pn * tstep;
    S.a_ready(cur);
    if constexpr (SP2) {
        PG8_STAGE(PG8_SB(0, 0), cB, voffB); PG8_STAGE(PG8_SB(0, 1), cB + hstep, voffB); PG8_STAGE(PG8_SA(0, 0), cA, voffA); PG8_STAGE(PG8_SA(0, 1), cA + hstep, voffA);
        if (wr == 1) PG8_BAR;
        PG8_WAIT_V(2); PG8_BAR;
        PG8_STAGE(PG8_SB(1, 0), cB + kstep, voffB); PG8_STAGE(PG8_SA(1, 0), cA + kstep, voffA); PG8_STAGE(PG8_SB(1, 1), cB + hstep + kstep, voffB);
        PG8_WAIT_V(6); PG8_BAR;
    } else {
        PG8_STAGE(PG8_SB(0, 0), cB, voffB); PG8_STAGE(PG8_SA(0, 0), cA, voffA); PG8_STAGE(PG8_SB(0, 1), cB + hstep, voffB); PG8_STAGE(PG8_SA(0, 1), cA + hstep, voffA);
        if (wr == 1) PG8_BAR;
        PG8_WAIT_V(4); PG8_BAR;
        PG8_STAGE(PG8_SB(1, 0), cB + kstep, voffB); PG8_STAGE(PG8_SA(1, 0), cA + kstep, voffA); PG8_STAGE(PG8_SB(1, 1), cB + hstep + kstep, voffB);
        PG8_WAIT_V(6); PG8_BAR;
    }
    for (;;) {
        const bool has_next = S.next(ui + 1, nxt);
        const char* nA = has_next ? (const char*)g.A + (size_t)nxt.pm * tstep : cA; const char* nB = has_next ? (const char*)g.Bt + (size_t)nxt.pn * tstep : cB;
        for (int t = 0; t < nt; t += 2) {
            const bool last = (t == nt - 2);
            const char* a1 = cA + (size_t)(t + 1) * kstep;
            const char* a2 = last ? nA : cA + (size_t)(t + 2) * kstep; const char* b2 = last ? nB : cB + (size_t)(t + 2) * kstep;
            const char* a3 = a2 + kstep; const char* b3 = b2 + kstep;
            if (last && has_next) S.a_ready(nxt);
            if constexpr (Epi::MIDK) { if (t == nt / 2) E.mid(acc, cur, wr, wc, fr, fq); }
            if constexpr (SP2) {
            PG8_LDB(B0, 0, 0); PG8_LDB(B1, 0, 1); PG8_SCHED; PG8_LDA(At, 0, 0); PG8_STAGE(PG8_SA(1, 1), a1 + hstep, voffA);
            PG8_WAIT_V(8); PG8_WAIT_L(0); PG8_BAR; PG8_MMA(0, 0, At, B0); PG8_MMA(0, 1, At, B1); PG8_BAR; PG8_SCHED;
            PG8_LDA(At, 0, 1); PG8_STAGE(PG8_SB(0, 0), b2, voffB); PG8_STAGE(PG8_SB(0, 1), b2 + hstep, voffB); PG8_STAGE(PG8_SA(0, 0), a2, voffA);
            PG8_WAIT_V(8); PG8_WAIT_L(0); PG8_BAR; PG8_MMA(1, 0, At, B0); PG8_MMA(1, 1, At, B1); PG8_BAR; PG8_SCHED;
            PG8_LDB(B0, 1, 0); PG8_LDB(B1, 1, 1); PG8_SCHED; PG8_LDA(At, 1, 0); PG8_STAGE(PG8_SA(0, 1), a2 + hstep, voffA);
            PG8_WAIT_V(8); PG8_WAIT_L(0); PG8_BAR; PG8_MMA(0, 0, At, B0); PG8_MMA(0, 1, At, B1); PG8_BAR; PG8_SCHED;
            PG8_LDA(At, 1, 1); PG8_STAGE(PG8_SB(1, 0), b3, voffB); PG8_STAGE(PG8_SB(1, 1), b3 + hstep, voffB); PG8_STAGE(PG8_SA(1, 0), a3, voffA);
            PG8_WAIT_V(8); PG8_WAIT_L(0); PG8_BAR; PG8_MMA(1, 0, At, B0); PG8_MMA(1, 1, At, B1); PG8_BAR; PG8_SCHED;
            } else {
            PG8_LDB(B0, 0, 0); PG8_SCHED; PG8_LDA(At, 0, 0); PG8_STAGE(PG8_SA(1, 1), a1 + hstep, voffA);
            PG8_WAIT_L(8); PG8_BAR; PG8_WAIT_L(0); PG8_MMA(0, 0, At, B0); PG8_BAR; PG8_SCHED;
            PG8_LDB(B1, 0, 1); PG8_STAGE(PG8_SB(0, 0), b2, voffB);
            PG8_BAR; PG8_WAIT_L(0); PG8_MMA(0, 1, At, B1); PG8_BAR;
            PG8_LDA(At, 0, 1); PG8_STAGE(PG8_SA(0, 0), a2, voffA);
            PG8_BAR; PG8_WAIT_L(0); PG8_MMA(1, 0, At, B0); PG8_BAR; PG8_SCHED;
            PG8_STAGE(PG8_SB(0, 1), b2 + hstep, voffB);
            PG8_WAIT_V(6); PG8_BAR; PG8_MMA(1, 1, At, B1); PG8_BAR;
            PG8_LDB(B0, 1, 0); PG8_SCHED; PG8_LDA(At, 1, 0); PG8_STAGE(PG8_SA(0, 1), a2 + hstep, voffA);
            PG8_WAIT_L(8); PG8_BAR; PG8_WAIT_L(0); PG8_MMA(0, 0, At, B0); PG8_BAR; PG8_SCHED;
            PG8_LDB(B1, 1, 1); PG8_STAGE(PG8_SB(1, 0), b3, voffB);
            PG8_BAR; PG8_WAIT_L(0); PG8_MMA(0, 1, At, B1); PG8_BAR;
            PG8_LDA(At, 1, 1); PG8_STAGE(PG8_SA(1, 0), a3, voffA);
            PG8_BAR; PG8_WAIT_L(0); PG8_MMA(1, 0, At, B0); PG8_BAR; PG8_SCHED;
            PG8_STAGE(PG8_SB(1, 1), b3 + hstep, voffB);
            PG8_WAIT_V(6); PG8_BAR; PG8_MMA(1, 1, At, B1); PG8_BAR;
            }
        }
        if constexpr (ALIGN_EPI) { if (wr == 0) PG8_BAR; }
        if constexpr (!Epi::AFTER_DRAIN) { E(acc, cur, wr, wc, fr, fq); S.done(cur); }
        if (!has_next) break;
#pragma unroll
        for (int a = 0; a < 2; ++a)
#pragma unroll
            for (int b = 0; b < 2; ++b)
#pragma unroll
                for (int m = 0; m < 4; ++m)
#pragma unroll
                    for (int n = 0; n < 2; ++n) acc[a][b][m][n] = (f32x4){0.f, 0.f, 0.f, 0.f};
        cur = nxt; cA = nA; cB = nB; ++ui;
        if constexpr (ALIGN_EPI) { if (wr == 1) PG8_BAR; }
    }
    PG8_WAIT_V(0);
    if constexpr (!ALIGN_EPI) { if (wr == 0) PG8_BAR; }
    PG8_BAR;
    if constexpr (Epi::AFTER_DRAIN) { E.fused(acc, cur, wr, wc, fr, fq, lds, wid, lane); S.done(cur); }
#undef PG8_SA
#undef PG8_SB
#undef PG8_STAGE
#undef PG8_LDA
#undef PG8_LDB
#undef PG8_MMA
#undef PG8_WAIT_V
#undef PG8_WAIT_L
#undef PG8_BAR
#undef PG8_SCHED
}
}
namespace att {
#define ATT_LAS __attribute__((address_space(3)))
typedef unsigned short bf16_t;
using bf16x8 = __attribute__((ext_vector_type(8))) short;
using s16x4  = __attribute__((ext_vector_type(4))) short;
using f32x16 = __attribute__((ext_vector_type(16))) float;
using f32x4v = __attribute__((ext_vector_type(4))) float;
using f32x2v = __attribute__((ext_vector_type(2))) float;
using u32x4  = __attribute__((ext_vector_type(4))) unsigned;
constexpr int KVBLK = 64, LDP = 9216, SEQL = 4096;
constexpr int PC_U = 0, PC_V = 1024, PC_Q = 2048, PC_K = 3072, PC_VA = 4096;
constexpr float SCALE = 0.125f;
constexpr float THR = 8.f;
constexpr int SHM_V = KVBLK * 128 * 2, SHM_K = KVBLK * 128 * 2, SHM_ATTN = 6 * SHM_V + 3 * SHM_K + 8 * 64 * 4 + 64;
static_assert(SHM_V == SHM_K, "one slot offset serves both rings");
#define KSWZ(row, colB) ((row) * 256 + ((colB) ^ (((row) & 7) << 4)))
#define SBAR() __builtin_amdgcn_sched_barrier(0)
__device__ __forceinline__ int crow(int r, int hi) { return (r & 3) + 8 * (r >> 2) + 4 * hi; }
__device__ __forceinline__ unsigned cvtpk(float lo, float hi) { unsigned r; asm volatile("v_cvt_pk_bf16_f32 %0, %1, %2" : "=v"(r) : "v"(lo), "v"(hi)); return r; }
__device__ __forceinline__ bf16x8 ld8(const bf16_t* p) { return *reinterpret_cast<const bf16x8*>(p); }
__device__ __forceinline__ float bf2f(short h) { return __uint_as_float(((unsigned)(unsigned short)h) << 16); }

__device__ __forceinline__ void partialSM(f32x16& p0, f32x16& p1, float& m_reg, float& mn, float& alpha) {
  constexpr float C = SCALE * 1.4426950408889634f;
  float pmax = p0[0];
#pragma unroll
  for (int r = 1; r < 16; ++r) pmax = fmaxf(pmax, p0[r]);
#pragma unroll
  for (int r = 0; r < 16; ++r) pmax = fmaxf(pmax, p1[r]);
  { auto rr = __builtin_amdgcn_permlane32_swap(__float_as_uint(pmax), __float_as_uint(pmax), false, false);
    pmax = fmaxf(__uint_as_float(rr[0]), __uint_as_float(rr[1])); }
  if (__builtin_expect(__all(pmax - m_reg <= THR / SCALE), 1)) { mn = m_reg; alpha = 1.f; }
  else { mn = fmaxf(m_reg, pmax); alpha = __builtin_amdgcn_exp2f((m_reg - mn) * C); m_reg = mn; }
  float mnC = -mn * C;
#ifdef PROBE_XEXP
  { float d0_, d1_, d2_, d3_;
#pragma unroll
    for (int r = 0; r < PROBE_XEXP; ++r) asm volatile(PROBE_XOP " %0, %4\n\t" PROBE_XOP " %1, %4\n\t" PROBE_XOP " %2, %4\n\t" PROBE_XOP " %3, %4" : "=&v"(d0_), "=&v"(d1_), "=&v"(d2_), "=&v"(d3_) : "v"(mnC)); }
#endif
#pragma unroll
  for (int r = 0; r < 16; ++r) p0[r] = fmaf(p0[r], C, mnC);
#pragma unroll
  for (int r = 0; r < 16; ++r) p1[r] = fmaf(p1[r], C, mnC);
#pragma unroll
  for (int r = 0; r < 16; ++r) p0[r] = __builtin_amdgcn_exp2f(p0[r]);
}
constexpr float THRL = 11.5f;
__device__ __forceinline__ void partialSM2(f32x16& p0, f32x16& p1, float& mref, f32x16& negm, float& alpha, bool first) {
  float pmax = p0[0];
#pragma unroll
  for (int r = 1; r < 16; ++r) pmax = fmaxf(pmax, p0[r]);
#pragma unroll
  for (int r = 0; r < 16; ++r) pmax = fmaxf(pmax, p1[r]);
  { auto rr = __builtin_amdgcn_permlane32_swap(__float_as_uint(pmax), __float_as_uint(pmax), false, false);
    pmax = fmaxf(__uint_as_float(rr[0]), __uint_as_float(rr[1])); }
  if (__builtin_expect(!first && __all(pmax <= THRL), 1)) { alpha = 1.f; }
  else { const float dl = first ? pmax : fmaxf(pmax, 0.f); mref += dl; alpha = first ? 0.f : __builtin_amdgcn_exp2f(-dl);
#pragma unroll
    for (int r = 0; r < 16; ++r) { p0[r] -= dl; p1[r] -= dl; }
#pragma unroll
    for (int r = 0; r < 16; ++r) negm[r] = -mref;
    asm volatile("" : "+v"(negm)); }
#pragma unroll
  for (int r = 0; r < 16; ++r) p0[r] = __builtin_amdgcn_exp2f(p0[r]);
}
__device__ __forceinline__ void finishSM(f32x16& p0, f32x16& p1, float alpha, float& l_reg, bf16x8& pa0, bf16x8& pa1, bf16x8& pa2, bf16x8& pa3, float* ps_out = nullptr) {
#pragma unroll
  for (int r = 0; r < 16; ++r) p1[r] = __builtin_amdgcn_exp2f(p1[r]);
  float ps = 0;
#pragma unroll
  for (int r = 0; r < 16; ++r) ps += p0[r];
#pragma unroll
  for (int r = 0; r < 16; ++r) ps += p1[r];
  { auto rr = __builtin_amdgcn_permlane32_swap(__float_as_uint(ps), __float_as_uint(ps), false, false);
    ps = __uint_as_float(rr[0]) + __uint_as_float(rr[1]); }
  l_reg = l_reg * alpha + ps; if (ps_out) *ps_out = ps;
#define PK4(P, BASE, OUT) do { unsigned a0 = cvtpk(P[BASE + 0], P[BASE + 1]), a1 = cvtpk(P[BASE + 2], P[BASE + 3]);   \
    unsigned b0 = cvtpk(P[BASE + 4], P[BASE + 5]), b1 = cvtpk(P[BASE + 6], P[BASE + 7]);                              \
    auto r0 = __builtin_amdgcn_permlane32_swap(a0, b0, false, false); auto r1 = __builtin_amdgcn_permlane32_swap(a1, b1, false, false); \
    u32x4 w = {r0[0], r1[0], r0[1], r1[1]}; OUT = *reinterpret_cast<bf16x8*>(&w); } while (0)
  PK4(p0, 0, pa0); PK4(p0, 8, pa1); PK4(p1, 0, pa2); PK4(p1, 8, pa3);
#undef PK4
}
__device__ __forceinline__ void finishSM_np(f32x16& p0, f32x16& p1, float alpha, float& l_reg, bf16x8& pa0, bf16x8& pa1, bf16x8& pa2, bf16x8& pa3, float* ps_out = nullptr, bool exp_p1 = true) {
  if (exp_p1) {
#pragma unroll
  for (int r = 0; r < 16; ++r) p1[r] = __builtin_amdgcn_exp2f(p1[r]); }
  float ps = 0;
#pragma unroll
  for (int r = 0; r < 16; ++r) ps += p0[r];
#pragma unroll
  for (int r = 0; r < 16; ++r) ps += p1[r];
  { auto rr = __builtin_amdgcn_permlane32_swap(__float_as_uint(ps), __float_as_uint(ps), false, false);
    ps = __uint_as_float(rr[0]) + __uint_as_float(rr[1]); }
  l_reg = l_reg * alpha + ps; if (ps_out) *ps_out = ps;
#define PK8(P, BASE, OUT) do { u32x4 w = {cvtpk(P[BASE + 0], P[BASE + 1]), cvtpk(P[BASE + 2], P[BASE + 3]), cvtpk(P[BASE + 4], P[BASE + 5]), cvtpk(P[BASE + 6], P[BASE + 7])}; OUT = *reinterpret_cast<bf16x8*>(&w); } while (0)
  PK8(p0, 0, pa0); PK8(p0, 8, pa1); PK8(p1, 0, pa2); PK8(p1, 8, pa3);
#undef PK8
}
__device__ __forceinline__ void qkt(f32x16& p0, f32x16& p1, const ATT_LAS char* Ks, const bf16x8* qr, int r32, int hi, int colb0) {
  p0 = f32x16{}; p1 = f32x16{};
#pragma unroll
  for (int d0 = 0; d0 < 4; ++d0) { const int cb = colb0 + (d0 * 16 + hi * 8) * 2;
    const bf16x8 b0 = *reinterpret_cast<const ATT_LAS bf16x8*>(Ks + KSWZ(r32, cb));
    const bf16x8 b1 = *reinterpret_cast<const ATT_LAS bf16x8*>(Ks + KSWZ(32 + r32, cb));
    p0 = __builtin_amdgcn_mfma_f32_32x32x16_bf16(b0, qr[d0], p0, 0, 0, 0);
    p1 = __builtin_amdgcn_mfma_f32_32x32x16_bf16(b1, qr[d0], p1, 0, 0, 0); }
}
__device__ __forceinline__ void qkt2(f32x16& p0, f32x16& p1, const ATT_LAS char* Ks, const bf16x8* qr, int r32, int hi, int colb0, const f32x16& negm) {
#pragma unroll
  for (int d0 = 0; d0 < 4; ++d0) { const int cb = colb0 + (d0 * 16 + hi * 8) * 2;
    const bf16x8 b0 = *reinterpret_cast<const ATT_LAS bf16x8*>(Ks + KSWZ(r32, cb));
    const bf16x8 b1 = *reinterpret_cast<const ATT_LAS bf16x8*>(Ks + KSWZ(32 + r32, cb));
    p0 = __builtin_amdgcn_mfma_f32_32x32x16_bf16(b0, qr[d0], d0 == 0 ? negm : p0, 0, 0, 0);
    p1 = __builtin_amdgcn_mfma_f32_32x32x16_bf16(b1, qr[d0], d0 == 0 ? negm : p1, 0, 0, 0); }
}
__device__ __forceinline__ int v_st(int k, int c) { const int kk = (k & ~0xC) | ((k & 4) << 1) | ((k & 8) >> 1); return ((kk >> 3) * 4 + (c >> 5)) * 512 + ((kk & 7) * 32 + (c & 31)) * 2; }
__device__ __forceinline__ int v_stp(int k, int c) { return ((k >> 3) * 4 + (c >> 5)) * 512 + ((k & 7) * 32 + (c & 31)) * 2; }
__device__ __forceinline__ int v_rd_base(int lane) { return ((lane & 3) << 3) | (((lane >> 2) & 3) << 6) | (((lane >> 4) & 1) << 5) | (((lane >> 5) & 1) << 8); }
constexpr int v_rd_off(int d0, int ks, int half) { return d0 * 512 + ks * 4096 + half * 2048; }
template <int OFF> __device__ __forceinline__ s16x4 tr_read(int vb) {
  s16x4 r; asm volatile("ds_read_b64_tr_b16 %0, %1 offset:%2" : "=&v"(r) : "v"(vb), "i"(OFF) : "memory"); return r;
}
template <int D0> __device__ __forceinline__ void pv_one(f32x16& od, int vb, bf16x8 pa0, bf16x8 pa1, bf16x8 pa2, bf16x8 pa3) {
  const s16x4 l0 = tr_read<v_rd_off(D0, 0, 0)>(vb), h0 = tr_read<v_rd_off(D0, 0, 1)>(vb), l1 = tr_read<v_rd_off(D0, 1, 0)>(vb), h1 = tr_read<v_rd_off(D0, 1, 1)>(vb);
  const s16x4 l2 = tr_read<v_rd_off(D0, 2, 0)>(vb), h2 = tr_read<v_rd_off(D0, 2, 1)>(vb), l3 = tr_read<v_rd_off(D0, 3, 0)>(vb), h3 = tr_read<v_rd_off(D0, 3, 1)>(vb);
  asm volatile("s_waitcnt lgkmcnt(0)" ::: "memory"); SBAR();
#define PK(L, H) (bf16x8){L[0], L[1], L[2], L[3], H[0], H[1], H[2], H[3]}
  od = __builtin_amdgcn_mfma_f32_32x32x16_bf16(pa0, PK(l0, h0), od, 0, 0, 0);
  od = __builtin_amdgcn_mfma_f32_32x32x16_bf16(pa1, PK(l1, h1), od, 0, 0, 0);
  od = __builtin_amdgcn_mfma_f32_32x32x16_bf16(pa2, PK(l2, h2), od, 0, 0, 0);
  od = __builtin_amdgcn_mfma_f32_32x32x16_bf16(pa3, PK(l3, h3), od, 0, 0, 0);
#undef PK
}
template <int D0, int SOFF> __device__ __forceinline__ void pv_one_s(f32x16& od, int vb, bf16x8 pa0, bf16x8 pa1, bf16x8 pa2, bf16x8 pa3) {
  const s16x4 l0 = tr_read<v_rd_off(D0, 0, 0) + SOFF>(vb), h0 = tr_read<v_rd_off(D0, 0, 1) + SOFF>(vb), l1 = tr_read<v_rd_off(D0, 1, 0) + SOFF>(vb), h1 = tr_read<v_rd_off(D0, 1, 1) + SOFF>(vb);
  const s16x4 l2 = tr_read<v_rd_off(D0, 2, 0) + SOFF>(vb), h2 = tr_read<v_rd_off(D0, 2, 1) + SOFF>(vb), l3 = tr_read<v_rd_off(D0, 3, 0) + SOFF>(vb), h3 = tr_read<v_rd_off(D0, 3, 1) + SOFF>(vb);
  asm volatile("s_waitcnt lgkmcnt(0)" ::: "memory"); SBAR();
#define PK(L, H) (bf16x8){L[0], L[1], L[2], L[3], H[0], H[1], H[2], H[3]}
  od = __builtin_amdgcn_mfma_f32_32x32x16_bf16(pa0, PK(l0, h0), od, 0, 0, 0);
  od = __builtin_amdgcn_mfma_f32_32x32x16_bf16(pa1, PK(l1, h1), od, 0, 0, 0);
  od = __builtin_amdgcn_mfma_f32_32x32x16_bf16(pa2, PK(l2, h2), od, 0, 0, 0);
  od = __builtin_amdgcn_mfma_f32_32x32x16_bf16(pa3, PK(l3, h3), od, 0, 0, 0);
#undef PK
}
template <int SOFF> __device__ __forceinline__ void pv_d0s(f32x16* o, int vb, bf16x8 pa0, bf16x8 pa1, bf16x8 pa2, bf16x8 pa3) {
  pv_one_s<0, SOFF>(o[0], vb, pa0, pa1, pa2, pa3); pv_one_s<1, SOFF>(o[1], vb, pa0, pa1, pa2, pa3); pv_one_s<2, SOFF>(o[2], vb, pa0, pa1, pa2, pa3); pv_one_s<3, SOFF>(o[3], vb, pa0, pa1, pa2, pa3);
}
__device__ __forceinline__ void pv_d0(f32x16* o, int vb, bf16x8 pa0, bf16x8 pa1, bf16x8 pa2, bf16x8 pa3) {
  pv_one<0>(o[0], vb, pa0, pa1, pa2, pa3); pv_one<1>(o[1], vb, pa0, pa1, pa2, pa3); pv_one<2>(o[2], vb, pa0, pa1, pa2, pa3); pv_one<3>(o[3], vb, pa0, pa1, pa2, pa3);
}
template <int D0> __device__ __forceinline__ void v_reads(s16x4 (&f)[8], int vb) {
  f[0] = tr_read<v_rd_off(D0, 0, 0)>(vb); f[1] = tr_read<v_rd_off(D0, 0, 1)>(vb); f[2] = tr_read<v_rd_off(D0, 1, 0)>(vb); f[3] = tr_read<v_rd_off(D0, 1, 1)>(vb);
  f[4] = tr_read<v_rd_off(D0, 2, 0)>(vb); f[5] = tr_read<v_rd_off(D0, 2, 1)>(vb); f[6] = tr_read<v_rd_off(D0, 3, 0)>(vb); f[7] = tr_read<v_rd_off(D0, 3, 1)>(vb);
}
__device__ __forceinline__ void pv_mma(f32x16& od, const s16x4 (&f)[8], bf16x8 pa0, bf16x8 pa1, bf16x8 pa2, bf16x8 pa3) {
#define PK(L, H) (bf16x8){L[0], L[1], L[2], L[3], H[0], H[1], H[2], H[3]}
  od = __builtin_amdgcn_mfma_f32_32x32x16_bf16(pa0, PK(f[0], f[1]), od, 0, 0, 0);
  od = __builtin_amdgcn_mfma_f32_32x32x16_bf16(pa1, PK(f[2], f[3]), od, 0, 0, 0);
  od = __builtin_amdgcn_mfma_f32_32x32x16_bf16(pa2, PK(f[4], f[5]), od, 0, 0, 0);
  od = __builtin_amdgcn_mfma_f32_32x32x16_bf16(pa3, PK(f[6], f[7]), od, 0, 0, 0);
#undef PK
}
template <int D0, int SOFF> __device__ __forceinline__ void v_reads_s(s16x4 (&f)[8], int vb) {
  f[0] = tr_read<v_rd_off(D0, 0, 0) + SOFF>(vb); f[1] = tr_read<v_rd_off(D0, 0, 1) + SOFF>(vb); f[2] = tr_read<v_rd_off(D0, 1, 0) + SOFF>(vb); f[3] = tr_read<v_rd_off(D0, 1, 1) + SOFF>(vb);
  f[4] = tr_read<v_rd_off(D0, 2, 0) + SOFF>(vb); f[5] = tr_read<v_rd_off(D0, 2, 1) + SOFF>(vb); f[6] = tr_read<v_rd_off(D0, 3, 0) + SOFF>(vb); f[7] = tr_read<v_rd_off(D0, 3, 1) + SOFF>(vb);
}
template <int SOFF> __device__ __forceinline__ void pv_pipe_s(f32x16* o, int vb, bf16x8 pa0, bf16x8 pa1, bf16x8 pa2, bf16x8 pa3) {
  s16x4 fa[8], fb[8];
  SBAR(); v_reads_s<0, SOFF>(fa, vb);
  v_reads_s<1, SOFF>(fb, vb); asm volatile("s_waitcnt lgkmcnt(8)" ::: "memory"); SBAR(); pv_mma(o[0], fa, pa0, pa1, pa2, pa3); SBAR();
  v_reads_s<2, SOFF>(fa, vb); asm volatile("s_waitcnt lgkmcnt(8)" ::: "memory"); SBAR(); pv_mma(o[1], fb, pa0, pa1, pa2, pa3); SBAR();
  v_reads_s<3, SOFF>(fb, vb); asm volatile("s_waitcnt lgkmcnt(8)" ::: "memory"); SBAR(); pv_mma(o[2], fa, pa0, pa1, pa2, pa3); SBAR();
  asm volatile("s_waitcnt lgkmcnt(0)" ::: "memory"); SBAR(); pv_mma(o[3], fb, pa0, pa1, pa2, pa3); SBAR();
}
__device__ __forceinline__ void pv_pipe(f32x16* o, int vb, bf16x8 pa0, bf16x8 pa1, bf16x8 pa2, bf16x8 pa3) {
  s16x4 fa[8], fb[8];
  SBAR(); v_reads<0>(fa, vb);
  v_reads<1>(fb, vb); asm volatile("s_waitcnt lgkmcnt(8)" ::: "memory"); SBAR(); pv_mma(o[0], fa, pa0, pa1, pa2, pa3); SBAR();
  v_reads<2>(fa, vb); asm volatile("s_waitcnt lgkmcnt(8)" ::: "memory"); SBAR(); pv_mma(o[1], fb, pa0, pa1, pa2, pa3); SBAR();
  v_reads<3>(fb, vb); asm volatile("s_waitcnt lgkmcnt(8)" ::: "memory"); SBAR(); pv_mma(o[2], fa, pa0, pa1, pa2, pa3); SBAR();
  asm volatile("s_waitcnt lgkmcnt(0)" ::: "memory"); SBAR(); pv_mma(o[3], fb, pa0, pa1, pa2, pa3); SBAR();
}

#ifndef ATT_ILV
#define ATT_ILV 1
#endif
#ifndef ATT_PVPIPE
#define ATT_PVPIPE 0
#endif
#ifndef ATT_FORCE_REDO
#define ATT_FORCE_REDO 0
#endif
template <bool FAST> __device__ __forceinline__ bool attn_unit_t(const bf16_t* __restrict__ QKV, bf16_t* __restrict__ BRB, int b, int h, int qb, float lam, float oml, const float* __restrict__ subg, ATT_LAS char* lds) {
  int tid_ = threadIdx.x; asm volatile("" : "+v"(tid_));
  const int tid = tid_, wid = __builtin_amdgcn_readfirstlane(tid >> 6), lane = tid & 63, r32 = lane & 31, hi = lane >> 5;
  const int map = wid >> 2, wq = wid & 3, colb0 = map * 128;
  ATT_LAS char* V_lds = lds; ATT_LAS char* K_lds = lds + 3 * SHM_V;
  ATT_LAS float* ws = (ATT_LAS float*)(lds + 3 * SHM_V + 3 * SHM_K) + wid * 64; ATT_LAS float* li_l = ws; ATT_LAS float* al_l = ws + 32;
  ATT_LAS unsigned* redo_w = (ATT_LAS unsigned*)(lds + 3 * SHM_V + 3 * SHM_K + 8 * 64 * 4);
  if (FAST && tid == 0) *redo_w = 0u;
  bool bad = false;
  float m_reg = 0.f, l_reg = 0; f32x16 o[4] = {}; bf16x8 qr[4]; f32x16 negm = {};
  const size_t tok0 = (size_t)b * SEQL + (size_t)qb * 128;
  constexpr int LDH = 128;
  const size_t hoff = (size_t)(b * 8 + h) * SEQL * LDH;
  const bf16_t* Kh = QKV + (size_t)32 * SEQL * LDH + hoff; const bf16_t* Vh = QKV + (size_t)64 * SEQL * LDH + hoff;
  const bf16_t* Qw = QKV + hoff + (size_t)(qb * 128 + wq * 32 + r32) * LDH + map * 64 + hi * 8;
#pragma unroll
  for (int d0 = 0; d0 < 4; ++d0) qr[d0] = ld8(Qw + d0 * 16);
  asm volatile("" :: "v"(qr[0]), "v"(qr[1]), "v"(qr[2]), "v"(qr[3]));
  const int sr = tid >> 4, sc = (tid & 15) * 8, vst0 = v_stp(sr, sc), vst1 = v_stp(32 + sr, sc);
  const int vb0 = (int)(uintptr_t)V_lds + v_rd_base(lane);
  struct { bf16x8 vs0, vs1, ks0, ks1; } sr_[1];
  const unsigned loff = (unsigned)(sr * LDH + sc) * 2u;
  const __amdgpu_buffer_rsrc_t rsK = __builtin_amdgcn_make_buffer_rsrc((void*)Kh, 0, SEQL * LDH * 2, 0x00020000);
  const __amdgpu_buffer_rsrc_t rsV = __builtin_amdgcn_make_buffer_rsrc((void*)Vh, 0, SEQL * LDH * 2, 0x00020000);
#define SLOAD(i, k0) do { const int so_ = (k0) * (LDH * 2); \
    sr_[i].vs0 = __builtin_bit_cast(bf16x8, __builtin_amdgcn_raw_buffer_load_b128(rsV, (int)loff, so_, 0)); sr_[i].vs1 = __builtin_bit_cast(bf16x8, __builtin_amdgcn_raw_buffer_load_b128(rsV, (int)loff, so_ + 32 * LDH * 2, 0)); \
    sr_[i].ks0 = __builtin_bit_cast(bf16x8, __builtin_amdgcn_raw_buffer_load_b128(rsK, (int)loff, so_, 0)); sr_[i].ks1 = __builtin_bit_cast(bf16x8, __builtin_amdgcn_raw_buffer_load_b128(rsK, (int)loff, so_ + 32 * LDH * 2, 0)); } while (0)
#define SWRITE(off, i) do { *(ATT_LAS bf16x8*)(V_lds + (off) + vst0) = sr_[i].vs0;          \
    *(ATT_LAS bf16x8*)(V_lds + (off) + vst1) = sr_[i].vs1; const int kc = sc * 2;               \
    *(ATT_LAS bf16x8*)(K_lds + (off) + KSWZ(sr, kc)) = sr_[i].ks0;                       \
    *(ATT_LAS bf16x8*)(K_lds + (off) + KSWZ(32 + sr, kc)) = sr_[i].ks1; } while (0)
#define SWAIT() do { } while (0)
#define RESC(a) do { if (__any((a) < 1.f)) { if (hi == 0) al_l[r32] = (a); asm volatile("s_waitcnt lgkmcnt(0)" ::: "memory"); \
    _Pragma("unroll") for (int d = 0; d < 4; ++d) _Pragma("unroll") for (int r = 0; r < 16; ++r) o[d][r] *= al_l[crow(r, hi)]; } } while (0)
#define ROT3() do { const int t_ = sl_prev; sl_prev = sl_cur; sl_cur = sl_next; sl_next = t_; } while (0)
#define PSM(X0, X1, alX) do { if (FAST) { alX = 1.f; _Pragma("unroll") for (int r_ = 0; r_ < 16; ++r_) X0[r_] = __builtin_amdgcn_exp2f(X0[r_]); } else partialSM2(X0, X1, m_reg, negm, alX, false); } while (0)
#define FSM(Y0, Y1, alY) do { if (FAST) { float ps_; finishSM_np(Y0, Y1, 1.f, l_reg, pa0, pa1, pa2, pa3, &ps_); bad |= !(ps_ < 1.2379400392853803e27f); } else finishSM_np(Y0, Y1, alY, l_reg, pa0, pa1, pa2, pa3); } while (0)
  f32x16 pA0, pA1, pB0, pB1; float alA, alB; bf16x8 pa0, pa1, pa2, pa3; constexpr int NT = SEQL / KVBLK;
  SLOAD(0, 0); asm volatile("s_waitcnt vmcnt(0)" ::: "memory"); SWRITE(0, 0); SLOAD(0, KVBLK); __syncthreads();
  qkt2(pA0, pA1, K_lds, qr, r32, hi, colb0, negm); partialSM2(pA0, pA1, m_reg, negm, alA, true);
  SWRITE(SHM_V, 0); SLOAD(0, 2 * KVBLK); __syncthreads();
#define ATT_STEP(X0, X1, alX, Y0, Y1, alY, j_, SP, SC, SN) do { \
    SBAR(); qkt2(X0, X1, K_lds + (SC), qr, r32, hi, colb0, negm); \
    FSM(Y0, Y1, alY); SBAR(); \
    pv_d0s<(SP)>(o, vb0, pa0, pa1, pa2, pa3); PSM(X0, X1, alX); \
    SWRITE((SN), 0); if ((j_) + 2 < NT) SLOAD(0, ((j_) + 2) * KVBLK); \
    if (!FAST) RESC(alX); __syncthreads(); } while (0)
  constexpr int S0 = 0, S1 = SHM_V, S2 = 2 * SHM_V;
  static_assert((NT - 4) % 6 == 0, "step loop: tiles 1 .. NT-4 in groups of six, then NT-3, NT-2, and the tail tile NT-1");
  for (int j = 1; j + 3 < NT; j += 6) {
    ATT_STEP(pB0, pB1, alB, pA0, pA1, alA, j,     S0, S1, S2);
    ATT_STEP(pA0, pA1, alA, pB0, pB1, alB, j + 1, S1, S2, S0);
    ATT_STEP(pB0, pB1, alB, pA0, pA1, alA, j + 2, S2, S0, S1);
    ATT_STEP(pA0, pA1, alA, pB0, pB1, alB, j + 3, S0, S1, S2);
    ATT_STEP(pB0, pB1, alB, pA0, pA1, alA, j + 4, S1, S2, S0);
    ATT_STEP(pA0, pA1, alA, pB0, pB1, alB, j + 5, S2, S0, S1);
  }
  ATT_STEP(pB0, pB1, alB, pA0, pA1, alA, NT - 3, S0, S1, S2);
  ATT_STEP(pA0, pA1, alA, pB0, pB1, alB, NT - 2, S1, S2, S0);
#undef ATT_STEP
  SBAR(); qkt2(pB0, pB1, K_lds + S0, qr, r32, hi, colb0, negm);
  FSM(pA0, pA1, alA); SBAR();
  pv_d0s<S2>(o, vb0, pa0, pa1, pa2, pa3); PSM(pB0, pB1, alB);
  if (!FAST) RESC(alB);
  FSM(pB0, pB1, alB); SBAR();
  pv_d0s<S0>(o, vb0, pa0, pa1, pa2, pa3);
#undef ROT3
#undef PSM
#undef FSM
  if (FAST) { if (__any(bad) && lane == 0) *redo_w = 1u; }
  if (hi == 0) li_l[r32] = l_reg; asm volatile("s_waitcnt lgkmcnt(0)" ::: "memory");
  float rli[16];
#pragma unroll
  for (int r = 0; r < 16; ++r) rli[r] = __builtin_amdgcn_rcpf(li_l[crow(r, hi)]);
  __syncthreads();
  if (FAST) { if (ATT_FORCE_REDO || __builtin_amdgcn_readfirstlane(*redo_w) != 0u) return true; }
  int tid2 = threadIdx.x; asm volatile("" : "+v"(tid2));
  const int lane2 = tid2 & 63, r32b = lane2 & 31, hib = lane2 >> 5;
  ATT_LAS float* ex = (ATT_LAS float*)lds + wq * 4096 + lane2;
  if (map == 1) {
#pragma unroll
    for (int d0 = 0; d0 < 4; ++d0)
#pragma unroll
      for (int r = 0; r < 16; ++r) ex[(d0 * 16 + r) * 64] = o[d0][r] * rli[r] * lam;
  }
  __syncthreads();
  if (map == 0) {
    float ss[16];
#pragma unroll
    for (int r = 0; r < 16; ++r) ss[r] = 0.f;
#pragma unroll
    for (int d0 = 0; d0 < 4; ++d0)
#pragma unroll
      for (int r = 0; r < 16; ++r) { const float v = o[d0][r] * rli[r] - ex[(d0 * 16 + r) * 64]; o[d0][r] = v; ss[r] += v * v; }
#pragma unroll
    for (int r = 0; r < 16; ++r) {
      float s = ss[r];
#define SHX(v_, o_) __uint_as_float((unsigned)__builtin_amdgcn_ds_bpermute((lane2 ^ (o_)) << 2, (int)__float_as_uint(v_)))
      s += SHX(s, 1); s += SHX(s, 2); s += SHX(s, 4); s += SHX(s, 8); s += SHX(s, 16);
#undef SHX
      ss[r] = oml / sqrtf(s * (1.0f / 128.0f) + 1e-6f);
    }
    ATT_LAS bf16_t* stg = (ATT_LAS bf16_t*)(lds + wq * 16384);
#pragma unroll
    for (int d0 = 0; d0 < 4; ++d0) { const float g = subg[d0 * 32 + r32b];
#pragma unroll
      for (int r = 0; r < 16; ++r) { const unsigned w = cvtpk(o[d0][r] * ss[r] * g, 0.f); stg[crow(r, hib) * 128 + d0 * 32 + r32b] = (bf16_t)(w & 0xffffu); } }
    asm volatile("s_waitcnt lgkmcnt(0)" ::: "memory");
    bf16_t* Ow = BRB + (tok0 + wq * 32) * 2048 + h * 128;
#pragma unroll
    for (int i = 0; i < 8; ++i) { const int id = i * 64 + lane2, row = id >> 4, ch = id & 15; *(bf16x8*)(Ow + (size_t)row * 2048 + ch * 8) = *(const ATT_LAS bf16x8*)(stg + row * 128 + ch * 8); }
  }
  __syncthreads();
#undef SLOAD
#undef SWRITE
#undef SWAIT
#undef RESC
  return false;
}

template <bool FAST> __device__ __forceinline__ bool attn_unit_d(const bf16_t* __restrict__ QKV, bf16_t* __restrict__ BRB, int b, int h, int qb, float lam, float oml, const float* __restrict__ subg, ATT_LAS char* lds) {
  int tid_ = threadIdx.x; asm volatile("" : "+v"(tid_));
  const int tid = tid_, wid = __builtin_amdgcn_readfirstlane(tid >> 6), lane = tid & 63, r32 = lane & 31, hi = lane >> 5;
  const int map = wid >> 2, wq = wid & 3, colb0 = map * 128;
  ATT_LAS char* V_lds = lds; ATT_LAS char* K_lds = lds + 6 * SHM_V;
  ATT_LAS float* ws = (ATT_LAS float*)(lds + 6 * SHM_V + 3 * SHM_K) + wid * 64; ATT_LAS float* li_l = ws; ATT_LAS float* al_l = ws + 32;
  ATT_LAS unsigned* redo_w = (ATT_LAS unsigned*)(lds + 6 * SHM_V + 3 * SHM_K + 8 * 64 * 4);
  if (FAST && tid == 0) *redo_w = 0u;
  bool bad = false;
  float m_reg = 0.f, l_reg = 0; f32x16 o[4] = {}; bf16x8 qr[4]; f32x16 negm = {};
  const size_t tok0 = (size_t)b * SEQL + (size_t)qb * 128;
  constexpr int LDH = 128;
  const size_t hoff = (size_t)(b * 8 + h) * SEQL * LDH;
  const bf16_t* Kh = QKV + (size_t)32 * SEQL * LDH + hoff; const bf16_t* Vh = QKV + (size_t)64 * SEQL * LDH + hoff;
  const int vb0 = (int)(uintptr_t)V_lds + v_rd_base(lane), vb3 = vb0 + 3 * SHM_V;
  const unsigned kvo0 = (unsigned)((8 * wid + (lane >> 4)) * 256 + (((lane & 15) ^ (lane >> 4)) << 4));
  const unsigned kvo1 = (unsigned)((8 * wid + (lane >> 4)) * 256 + 1024 + (((lane & 15) ^ ((lane >> 4) + 4)) << 4));
  const unsigned vvo0 = (unsigned)((8 * wid + ((lane & 31) >> 2)) * 256 + (lane >> 5) * 64 + (lane & 3) * 16), vvo1 = vvo0 + 128u;
  const unsigned kd0 = (unsigned)__builtin_amdgcn_readfirstlane((int)((unsigned)(uintptr_t)K_lds + (unsigned)wid * 2048u)), vd0 = (unsigned)__builtin_amdgcn_readfirstlane((int)((unsigned)(uintptr_t)V_lds + (unsigned)wid * 2048u));
#define ADMA(voff, sbase, ldsdst) do { unsigned keep_; asm volatile("s_mov_b32 %0, m0\n\ts_mov_b32 m0, %3\n\ts_nop 0\n\tglobal_load_lds_dwordx4 %1, %2\n\ts_mov_b32 m0, %0" : "=&s"(keep_) : "v"(voff), "s"(sbase), "s"(ldsdst) : "memory"); } while (0)
#define DMA(t, KS, VS) do { const char* kt_ = (const char*)Kh + (size_t)(t) * (KVBLK * LDH * 2); const char* vt_ = (const char*)Vh + (size_t)(t) * (KVBLK * LDH * 2); \
    ADMA(kvo0, kt_, kd0 + (unsigned)((KS) * SHM_K)); ADMA(kvo1, kt_, kd0 + (unsigned)((KS) * SHM_K) + 1024u); ADMA(vvo0, vt_, vd0 + (unsigned)((VS) * SHM_V)); ADMA(vvo1, vt_, vd0 + (unsigned)((VS) * SHM_V) + 1024u); } while (0)
#define DWAIT4() asm volatile("s_waitcnt vmcnt(4)" ::: "memory")
#define DWAIT0() asm volatile("s_waitcnt vmcnt(0)" ::: "memory")
  DMA(0, 0, 0); DMA(1, 1, 1);
  const bf16_t* Qw = QKV + hoff + (size_t)(qb * 128 + wq * 32 + r32) * LDH + map * 64 + hi * 8;
#pragma unroll
  for (int d0 = 0; d0 < 4; ++d0) qr[d0] = ld8(Qw + d0 * 16);
  asm volatile("" :: "v"(qr[0]), "v"(qr[1]), "v"(qr[2]), "v"(qr[3]));
  int kof[4];
#pragma unroll
  for (int d0 = 0; d0 < 4; ++d0) kof[d0] = KSWZ(r32, colb0 + (d0 * 16 + hi * 8) * 2);
#define RESC(a) do { if (__any((a) < 1.f)) { if (hi == 0) al_l[r32] = (a); asm volatile("s_waitcnt lgkmcnt(0)" ::: "memory"); \
    _Pragma("unroll") for (int d = 0; d < 4; ++d) _Pragma("unroll") for (int r = 0; r < 16; ++r) o[d][r] *= al_l[crow(r, hi)]; } } while (0)
#define ROT3() do { const int t_ = sl_prev; sl_prev = sl_cur; sl_cur = sl_next; sl_next = t_; } while (0)
#define PSM(X0, X1, alX) do { if (FAST) { alX = 1.f; _Pragma("unroll") for (int r_ = 0; r_ < 16; ++r_) X0[r_] = __builtin_amdgcn_exp2f(X0[r_]); } else partialSM2(X0, X1, m_reg, negm, alX, false); } while (0)
#define FSM(Y0, Y1, alY) do { if (FAST) { float ps_; finishSM_np(Y0, Y1, 1.f, l_reg, pa0, pa1, pa2, pa3, &ps_); bad |= !(ps_ < 1.2379400392853803e27f); } else finishSM_np(Y0, Y1, alY, l_reg, pa0, pa1, pa2, pa3); } while (0)
  f32x16 pA0, pA1, pB0, pB1; float alA, alB; bf16x8 pa0, pa1, pa2, pa3; constexpr int NT = SEQL / KVBLK;
  DWAIT4(); __syncthreads();
  qkt2(pA0, pA1, K_lds, qr, r32, hi, colb0, negm); partialSM2(pA0, pA1, m_reg, negm, alA, true);
  if (FAST && ATT_ILV) {
#pragma unroll
    for (int r = 0; r < 16; ++r) pA1[r] = __builtin_amdgcn_exp2f(pA1[r]); }
  DMA(2, 2, 2); DWAIT4(); __syncthreads();
#define PVS(VP) do { if (FAST && ATT_PVPIPE) { if ((VP) < 3) pv_pipe_s<(VP) * SHM_V>(o, vb0, pa0, pa1, pa2, pa3); else pv_pipe_s<((VP) - 3) * SHM_V>(o, vb3, pa0, pa1, pa2, pa3); } \
    else { if ((VP) < 3) pv_d0s<(VP) * SHM_V>(o, vb0, pa0, pa1, pa2, pa3); else pv_d0s<((VP) - 3) * SHM_V>(o, vb3, pa0, pa1, pa2, pa3); } } while (0)
#define KRD(KC, d0_, o_) (*reinterpret_cast<const ATT_LAS bf16x8*>(K_lds + (KC) * SHM_K + kof[d0_] + (o_)))
#define MF32(A_, B_, C_) __builtin_amdgcn_mfma_f32_32x32x16_bf16(A_, B_, C_, 0, 0, 0)
#define G1(ACC, KF, d0_, CIN, W, wa, wb, P, pb, Yv, ya) do { ACC = MF32(KF, qr[d0_], CIN); W[wa] = cvtpk(P[pb], P[pb + 1]); W[wb] = cvtpk(P[pb + 2], P[pb + 3]); ps_ += Yv[ya]; ps_ += Yv[ya + 1]; SBAR(); } while (0)
#define PKF(F, i_) (bf16x8){F[2 * (i_)][0], F[2 * (i_)][1], F[2 * (i_)][2], F[2 * (i_)][3], F[2 * (i_) + 1][0], F[2 * (i_) + 1][1], F[2 * (i_) + 1][2], F[2 * (i_) + 1][3]}
#define G2(OD, PA_, F, i_, XE, xe, Yv, ya) do { OD = MF32(PA_, PKF(F, i_), OD); XE[xe] = __builtin_amdgcn_exp2f(XE[xe]); XE[xe + 1] = __builtin_amdgcn_exp2f(XE[xe + 1]); ps_ += Yv[ya]; SBAR(); } while (0)
#define PVBLK(d0_, F, XE, xb, yb) do { G2(o[d0_], pa0, F, 0, XE, xb, Y1_, yb); G2(o[d0_], pa1, F, 1, XE, xb + 2, Y1_, yb + 1); G2(o[d0_], pa2, F, 2, XE, xb + 4, Y1_, yb + 2); G2(o[d0_], pa3, F, 3, XE, xb + 6, Y1_, yb + 3); } while (0)
  bf16x8 ka_, kb_, kc_, kd_;
  if (FAST && ATT_ILV) { ka_ = KRD(1, 0, 0); kb_ = KRD(1, 0, 8192); kc_ = KRD(1, 1, 0); kd_ = KRD(1, 1, 8192); }
#define FSTEP(X0, X1, Y0, Y1, j_, KC, VP, KD, VD, KN) do { \
    SBAR(); \
    { f32x16& Y1_ = Y1; float ps_ = 0.f; u32x4 w0_, w1_, w2_, w3_; \
      G1(X0, ka_, 0, negm, w0_, 0, 1, Y0, 0, Y0, 0);  G1(X1, kb_, 0, negm, w0_, 2, 3, Y0, 4, Y0, 2); \
      ka_ = KRD(KC, 2, 0); kb_ = KRD(KC, 2, 8192); \
      G1(X0, kc_, 1, X0, w1_, 0, 1, Y0, 8, Y0, 4);    G1(X1, kd_, 1, X1, w1_, 2, 3, Y0, 12, Y0, 6); \
      kc_ = KRD(KC, 3, 0); kd_ = KRD(KC, 3, 8192); \
      if ((j_) + 2 < NT) DMA((j_) + 2, KD, VD);     \
      SBAR(); \
      G1(X0, ka_, 2, X0, w2_, 0, 1, Y1, 0, Y0, 8);    G1(X1, kb_, 2, X1, w2_, 2, 3, Y1, 4, Y0, 10); \
      G1(X0, kc_, 3, X0, w3_, 0, 1, Y1, 8, Y0, 12);   G1(X1, kd_, 3, X1, w3_, 2, 3, Y1, 12, Y0, 14); \
      pa0 = __builtin_bit_cast(bf16x8, w0_); pa1 = __builtin_bit_cast(bf16x8, w1_); pa2 = __builtin_bit_cast(bf16x8, w2_); pa3 = __builtin_bit_cast(bf16x8, w3_); \
      { constexpr int VO_ = ((VP) < 3 ? (VP) : (VP) - 3) * SHM_V; const int vbb_ = (VP) < 3 ? vb0 : vb3; s16x4 fa_[8], fb_[8]; \
        v_reads_s<0, VO_>(fa_, vbb_); \
        v_reads_s<1, VO_>(fb_, vbb_); \
        if ((j_) + 2 < NT) DWAIT4(); else DWAIT0(); \
        asm volatile("s_barrier" ::: "memory"); \
        asm volatile("s_waitcnt lgkmcnt(8)" ::: "memory"); SBAR(); PVBLK(0, fa_, X0, 0, 0); \
        v_reads_s<2, VO_>(fa_, vbb_); asm volatile("s_waitcnt lgkmcnt(8)" ::: "memory"); SBAR(); PVBLK(1, fb_, X0, 8, 4); \
        v_reads_s<3, VO_>(fb_, vbb_); asm volatile("s_waitcnt lgkmcnt(8)" ::: "memory"); SBAR(); PVBLK(2, fa_, X1, 0, 8); \
        if ((KN) >= 0) { ka_ = KRD((KN) < 0 ? 0 : (KN), 0, 0); kb_ = KRD((KN) < 0 ? 0 : (KN), 0, 8192); kc_ = KRD((KN) < 0 ? 0 : (KN), 1, 0); kd_ = KRD((KN) < 0 ? 0 : (KN), 1, 8192); \
                         asm volatile("s_waitcnt lgkmcnt(4)" ::: "memory"); } else asm volatile("s_waitcnt lgkmcnt(0)" ::: "memory"); \
        SBAR(); PVBLK(3, fb_, X1, 8, 12); } \
      { auto rr_ = __builtin_amdgcn_permlane32_swap(__float_as_uint(ps_), __float_as_uint(ps_), false, false); ps_ = __uint_as_float(rr_[0]) + __uint_as_float(rr_[1]); } \
      l_reg += ps_; bad |= !(ps_ < 1.2379400392853803e27f); } } while (0)
#define ATT_STEP(X0, X1, alX, Y0, Y1, alY, j_, KC, VP, KD, VD) do { \
    if ((j_) + 2 < NT) DMA((j_) + 2, KD, VD); \
    SBAR(); qkt2(X0, X1, K_lds + (KC) * SHM_K, qr, r32, hi, colb0, negm); \
    FSM(Y0, Y1, alY); SBAR(); \
    PVS(VP); PSM(X0, X1, alX); \
    if (!FAST) RESC(alX); \
    if ((j_) + 2 < NT) DWAIT4(); else DWAIT0(); __syncthreads(); } while (0)
  static_assert((NT - 4) % 6 == 0, "step loop: tiles 1 .. NT-4 in groups of six, then NT-3, NT-2, and the tail tile NT-1");
#define STEP_(X0, X1, alX, Y0, Y1, alY, j_, KC, VP, KD, VD) do { if (FAST && ATT_ILV) FSTEP(X0, X1, Y0, Y1, j_, KC, VP, KD, VD, ((KC) + 1) % 3); else ATT_STEP(X0, X1, alX, Y0, Y1, alY, j_, KC, VP, KD, VD); } while (0)
  for (int j = 1; j + 3 < NT; j += 6) {
    STEP_(pB0, pB1, alB, pA0, pA1, alA, j,     1, 0, 0, 3);
    STEP_(pA0, pA1, alA, pB0, pB1, alB, j + 1, 2, 1, 1, 4);
    STEP_(pB0, pB1, alB, pA0, pA1, alA, j + 2, 0, 2, 2, 5);
    STEP_(pA0, pA1, alA, pB0, pB1, alB, j + 3, 1, 3, 0, 0);
    STEP_(pB0, pB1, alB, pA0, pA1, alA, j + 4, 2, 4, 1, 1);
    STEP_(pA0, pA1, alA, pB0, pB1, alB, j + 5, 0, 5, 2, 2);
  }
  STEP_(pB0, pB1, alB, pA0, pA1, alA, NT - 3, 1, 0, 0, 3);
  STEP_(pA0, pA1, alA, pB0, pB1, alB, NT - 2, 2, 1, 1, 4);
  if (FAST && ATT_ILV) {
    FSTEP(pB0, pB1, pA0, pA1, NT - 1, 0, 2, 0, 0, -1);
    { float ps_; finishSM_np(pB0, pB1, 1.f, l_reg, pa0, pa1, pa2, pa3, &ps_, false); bad |= !(ps_ < 1.2379400392853803e27f); }
    SBAR(); PVS(3);
  } else {
  SBAR(); qkt2(pB0, pB1, K_lds + 0 * SHM_K, qr, r32, hi, colb0, negm);
  FSM(pA0, pA1, alA); SBAR();
  PVS(2); PSM(pB0, pB1, alB);
  if (!FAST) RESC(alB);
  FSM(pB0, pB1, alB); SBAR();
  PVS(3);
  }
#undef ATT_STEP
#undef STEP_
#undef FSTEP
#undef KRD
#undef MF32
#undef G1
#undef G2
#undef PKF
#undef PVBLK
#undef PVS
#undef ROT3
#undef PSM
#undef FSM
  if (FAST) { if (__any(bad) && lane == 0) *redo_w = 1u; }
  if (hi == 0) li_l[r32] = l_reg; asm volatile("s_waitcnt lgkmcnt(0)" ::: "memory");
  float rli[16];
#pragma unroll
  for (int r = 0; r < 16; ++r) rli[r] = __builtin_amdgcn_rcpf(li_l[crow(r, hi)]);
  __syncthreads();
  if (FAST) { if (ATT_FORCE_REDO || __builtin_amdgcn_readfirstlane(*redo_w) != 0u) return true; }
  int tid2 = threadIdx.x; asm volatile("" : "+v"(tid2));
  const int lane2 = tid2 & 63, r32b = lane2 & 31, hib = lane2 >> 5;
  ATT_LAS float* ex = (ATT_LAS float*)lds + wq * 4096 + lane2;
  if (map == 1) {
#pragma unroll
    for (int d0 = 0; d0 < 4; ++d0)
#pragma unroll
      for (int r = 0; r < 16; ++r) ex[(d0 * 16 + r) * 64] = o[d0][r] * rli[r] * lam;
  }
  __syncthreads();
  if (map == 0) {
    float ss[16];
#pragma unroll
    for (int r = 0; r < 16; ++r) ss[r] = 0.f;
#pragma unroll
    for (int d0 = 0; d0 < 4; ++d0)
#pragma unroll
      for (int r = 0; r < 16; ++r) { const float v = o[d0][r] * rli[r] - ex[(d0 * 16 + r) * 64]; o[d0][r] = v; ss[r] += v * v; }
#pragma unroll
    for (int r = 0; r < 16; ++r) {
      float s = ss[r];
#define SHX(v_, o_) __uint_as_float((unsigned)__builtin_amdgcn_ds_bpermute((lane2 ^ (o_)) << 2, (int)__float_as_uint(v_)))
      s += SHX(s, 1); s += SHX(s, 2); s += SHX(s, 4); s += SHX(s, 8); s += SHX(s, 16);
#undef SHX
      ss[r] = oml / sqrtf(s * (1.0f / 128.0f) + 1e-6f);
    }
    ATT_LAS bf16_t* stg = (ATT_LAS bf16_t*)(lds + wq * 16384);
#pragma unroll
    for (int d0 = 0; d0 < 4; ++d0) { const float g = subg[d0 * 32 + r32b];
#pragma unroll
      for (int r = 0; r < 16; ++r) { const unsigned w = cvtpk(o[d0][r] * ss[r] * g, 0.f); stg[crow(r, hib) * 128 + d0 * 32 + r32b] = (bf16_t)(w & 0xffffu); } }
    asm volatile("s_waitcnt lgkmcnt(0)" ::: "memory");
    bf16_t* Ow = BRB + (tok0 + wq * 32) * 2048 + h * 128;
#pragma unroll
    for (int i = 0; i < 8; ++i) { const int id = i * 64 + lane2, row = id >> 4, ch = id & 15; *(bf16x8*)(Ow + (size_t)row * 2048 + ch * 8) = *(const ATT_LAS bf16x8*)(stg + row * 128 + ch * 8); }
  }
  __syncthreads();
#undef ADMA
#undef DMA
#undef DWAIT4
#undef DWAIT0
#undef RESC
  return false;
}


constexpr int GM_ST = 32768, GM_U = 36864, GM_O = GM_U + 32768, GM_END = GM_O + 32768;
template <bool DYN> __device__ __forceinline__ void gmlp_units(const bf16_t* __restrict__ P, bf16_t* __restrict__ BRA, const f32x2v* __restrict__ vstat, const bf16_t* __restrict__ WSb, const float* __restrict__ bs,
                                           const float* __restrict__ lng, const float* __restrict__ lnb, int u0, int ustep, int nunits, ATT_LAS char* lds, unsigned* gq = nullptr, volatile ATT_LAS unsigned* gw = nullptr) {
  int tid_ = threadIdx.x; asm volatile("" : "+v"(tid_));
  const int tid = tid_, wid = __builtin_amdgcn_readfirstlane(tid >> 6), lane = tid & 63, r32 = lane & 31, hi = lane >> 5;
  const int pblk = wid & 3, dpair = wid >> 2;
  ATT_LAS f32x2v* st = (ATT_LAS f32x2v*)(lds + GM_ST);
  const int sr = tid >> 4, sc = (tid & 15) * 8;
  bf16x8 af[8], xv[4], xu[4]; f32x4v g0, g1, b0, b1, t[8]; float bsv[16];
#define GM_LOAD_X(u_) do { const int g_ = (u_) & 7, bn_ = (u_) >> 3; const size_t tok_ = (size_t)(bn_ >> 5) * SEQL + (size_t)(bn_ & 31) * 128; \
    _Pragma("unroll") for (int j = 0; j < 4; ++j) { const bf16_t* rp = P + (tok_ + sr + 32 * j) * LDP + g_ * 128 + sc; xv[j] = __builtin_nontemporal_load((const bf16x8*)(rp + PC_V)); xu[j] = __builtin_nontemporal_load((const bf16x8*)(rp + PC_U)); } \
    if (tid < 128) { const f32x4v* sp = (const f32x4v*)(vstat + (tok_ + tid) * 16); _Pragma("unroll") for (int i = 0; i < 8; ++i) t[i] = __builtin_nontemporal_load(&sp[i]); } } while (0)
#define GM_LOAD_W(u_) do { const int g_ = (u_) & 7; const bf16_t* wrow = WSb + ((size_t)g_ * 128 + pblk * 32 + r32) * 128 + hi * 8; \
    _Pragma("unroll") for (int ks = 0; ks < 8; ++ks) af[ks] = ld8(wrow + ks * 16); \
    g0 = *(const f32x4v*)(lng + g_ * 128 + sc); g1 = *(const f32x4v*)(lng + g_ * 128 + sc + 4); b0 = *(const f32x4v*)(lnb + g_ * 128 + sc); b1 = *(const f32x4v*)(lnb + g_ * 128 + sc + 4); \
    _Pragma("unroll") for (int r = 0; r < 16; ++r) bsv[r] = bs[g_ * 128 + pblk * 32 + crow(r, hi)]; } while (0)
  unsigned unq = (unsigned)nunits;
  if (DYN && tid == 0) unq = __hip_atomic_fetch_add(gq, 1u, __ATOMIC_RELAXED, __HIP_MEMORY_SCOPE_AGENT);
  if (u0 < nunits) { GM_LOAD_X(u0); GM_LOAD_W(u0); }
  for (int u = u0; u < nunits; ) {
    const int g = u & 7, bn = u >> 3; const size_t tok0 = (size_t)(bn >> 5) * SEQL + (size_t)(bn & 31) * 128; const int ch0 = g * 128;
    if (tid < 128) {
      float ms = 0.f;
#pragma unroll
      for (int i = 0; i < 8; ++i) ms += t[i][0] + t[i][2];
      const float mean = ms * (1.0f / 16.0f); float m2 = 0.f;
#pragma unroll
      for (int i = 0; i < 8; ++i) { const float d0 = t[i][0] - mean, d1 = t[i][2] - mean; m2 += t[i][1] + t[i][3] + 64.0f * (d0 * d0 + d1 * d1); }
      st[tid] = (f32x2v){mean, 1.0f / sqrtf(m2 * (1.0f / 1024.0f) + 1e-6f)};
    }
#pragma unroll
    for (int j = 0; j < 4; ++j) *(ATT_LAS bf16x8*)(lds + GM_U + (sr + 32 * j) * 256 + sc * 2) = xu[j];
    if (DYN && tid == 0) { gw[0] = unq; unq = __hip_atomic_fetch_add(gq, 1u, __ATOMIC_RELAXED, __HIP_MEMORY_SCOPE_AGENT); }
    __syncthreads();
    const int un = DYN ? __builtin_amdgcn_readfirstlane((int)gw[0]) : u + ustep;
#pragma unroll
    for (int j = 0; j < 4; ++j) { const int q = sr + 32 * j; const bf16x8 x = xv[j]; const f32x2v mr = st[q];
      u32x4 w;
      w.x = cvtpk((bf2f(x[0]) - mr.x) * mr.y * g0[0] + b0[0], (bf2f(x[1]) - mr.x) * mr.y * g0[1] + b0[1]);
      w.y = cvtpk((bf2f(x[2]) - mr.x) * mr.y * g0[2] + b0[2], (bf2f(x[3]) - mr.x) * mr.y * g0[3] + b0[3]);
      w.z = cvtpk((bf2f(x[4]) - mr.x) * mr.y * g1[0] + b1[0], (bf2f(x[5]) - mr.x) * mr.y * g1[1] + b1[1]);
      w.w = cvtpk((bf2f(x[6]) - mr.x) * mr.y * g1[2] + b1[2], (bf2f(x[7]) - mr.x) * mr.y * g1[3] + b1[3]);
      *(ATT_LAS u32x4*)(lds + (q >> 6) * SHM_V + v_st(q & 63, sc)) = w; }
    const bool more = un < nunits;
    if (more) GM_LOAD_X(un);
    __syncthreads();
    const int vb = (int)(uintptr_t)lds + v_rd_base(lane) + dpair * 1024;
    f32x16 o0 = {}, o1 = {};
    pv_one<0>(o0, vb, af[0], af[1], af[2], af[3]); pv_one<0>(o0, vb + SHM_V, af[4], af[5], af[6], af[7]);
    pv_one<1>(o1, vb, af[0], af[1], af[2], af[3]); pv_one<1>(o1, vb + SHM_V, af[4], af[5], af[6], af[7]);
    { const ATT_LAS bf16_t* Ul = (const ATT_LAS bf16_t*)(lds + GM_U) + (pblk * 32) * 128 + dpair * 64 + r32;
      ATT_LAS bf16_t* Ol = (ATT_LAS bf16_t*)(lds + GM_O) + (pblk * 32) * 128 + dpair * 64 + r32;
#pragma unroll
      for (int r = 0; r < 16; ++r) { const int p = crow(r, hi);
        const float u0_ = bf2f((short)Ul[p * 128]), u1_ = bf2f((short)Ul[p * 128 + 32]);
        const unsigned w0 = cvtpk(u0_ * (o0[r] + bsv[r]), 0.f), w1 = cvtpk(u1_ * (o1[r] + bsv[r]), 0.f);
        Ol[p * 128] = (bf16_t)(w0 & 0xffffu); Ol[p * 128 + 32] = (bf16_t)(w1 & 0xffffu); } }
    if (more) GM_LOAD_W(un);
    __syncthreads();
#pragma unroll
    for (int j = 0; j < 4; ++j) { const int q = sr + 32 * j; *(bf16x8*)(BRA + (tok0 + q) * 2048 + ch0 + sc) = *(const ATT_LAS bf16x8*)(lds + GM_O + q * 256 + sc * 2); }
    u = un;
  }
#undef GM_LOAD_X
#undef GM_LOAD_W
}
#undef KSWZ
#undef SBAR
}
#define GAS __attribute__((address_space(1)))
#define LAS __attribute__((address_space(3)))
typedef unsigned short bf16;
typedef unsigned v4u __attribute__((ext_vector_type(4)));
typedef float f32x4 __attribute__((ext_vector_type(4)));
typedef short bf16x8 __attribute__((ext_vector_type(8)));
typedef GAS unsigned gu32;
typedef GAS unsigned long long gu64;
#define RLX_AGENT __ATOMIC_RELAXED, __HIP_MEMORY_SCOPE_AGENT
#define LDS_WAIT() asm volatile("s_waitcnt lgkmcnt(0)" ::: "memory")
#define VM_WAIT() asm volatile("s_waitcnt vmcnt(0)" ::: "memory")
__device__ __forceinline__ unsigned long long rt() { return __builtin_amdgcn_s_memrealtime(); }
__device__ __forceinline__ unsigned f2bf(float f) { unsigned u = __builtin_bit_cast(unsigned, f); return (u + 0x7fffu + ((u >> 16) & 1u)) >> 16; }
__device__ __forceinline__ unsigned pk2(float lo, float hi) { return f2bf(lo) | (f2bf(hi) << 16); }

#define XB_TMO      128
#define XB_XCNT(j)  (256  + 64 * (j))
#define XB_XSUB(j)  (1280 + 64 * (j))
#define XB_XGEN(j)  (2304 + 64 * (j))
#define XB_TOP      3328
#define XB_TOPGEN   3392
#define XCD_BAR_WORDS 3456
#define XB_LSUB(j)  (3456 + 64 * (j))
#define XB_LGEN(j)  (4096 + 64 * (j))
#define XB_GRPX(j)  (4608 + 64 * (j))
#define XB_QSUB(q)  (8192 + 64 * (q))
#define XB_QGEN(q)  (12288 + 64 * (q))
#define XB_NONLOC   5184
#define XB_SPIN_CAP (1u << 18)

__device__ __forceinline__ unsigned xb_ld(unsigned* p)              { return __hip_atomic_load(p, __ATOMIC_RELAXED, __HIP_MEMORY_SCOPE_AGENT); }
__device__ __forceinline__ unsigned xb_add(unsigned* p, unsigned v) { return __hip_atomic_fetch_add(p, v, __ATOMIC_RELAXED, __HIP_MEMORY_SCOPE_AGENT); }
__device__ __forceinline__ unsigned xb_xcc_id() { return (unsigned)__builtin_amdgcn_s_getreg((3 << 11) | 20) & 0xFu; }
#define XB_SPIN(cond, bar) do { unsigned _sp = 0; while (cond) { __builtin_amdgcn_s_sleep(1); \
    if ((++_sp & 255u) == 0u) { if (xb_ld(&(bar)[XB_TMO])) break; if (_sp > XB_SPIN_CAP) { atomicAdd(&(bar)[XB_TMO], 1u); break; } } } } while (0)

struct XcdBarrier {
    unsigned* bar; unsigned x;
    volatile LAS unsigned* st;
};

__device__ __forceinline__ XcdBarrier xcd_barrier_post(unsigned* bar, volatile LAS unsigned* st) {
    XcdBarrier b; b.bar = bar; b.x = xb_xcc_id(); b.st = st;
    if (threadIdx.x == 0) { (void)xb_add(&bar[XB_XCNT(b.x)], 1u);
        const unsigned g_ = blockIdx.x & 7u, me_ = b.x + 1u; const unsigned old_ = atomicCAS(&bar[XB_GRPX(g_)], 0u, me_);
        if ((old_ != 0u && old_ != me_) || gridDim.x != 256u) (void)xb_add(&bar[XB_NONLOC], 1u); }
    return b;
}
__device__ __forceinline__ void xcd_barrier_complete(unsigned* bar, unsigned x, unsigned& nloc, unsigned& nx) {
    const unsigned G = gridDim.x * gridDim.y * gridDim.z;
    unsigned sum, cnt, mine, sp = 0u;
    for (;;) {
        sum = 0u; cnt = 0u; mine = 0u;
#pragma unroll
        for (unsigned j = 0; j < 16; ++j) { const unsigned c = xb_ld(&bar[XB_XCNT(j)]); sum += c; cnt += (c > 0u) ? 1u : 0u; mine = (j == x) ? c : mine; }
        if (sum == G) break;
        __builtin_amdgcn_s_sleep(1);
        if ((++sp & 255u) == 0u) { if (xb_ld(&bar[XB_TMO])) break; if (sp > XB_SPIN_CAP) { atomicAdd(&bar[XB_TMO], 1u); break; } }
    }
    nloc = mine > 0u ? mine : 1u; nx = cnt > 0u ? cnt : 1u;
}

__device__ __forceinline__ void xcd_barrier(const XcdBarrier& b) {
    asm volatile("s_waitcnt vmcnt(0)" ::: "memory");
    __syncthreads();
    int xb_tid_ = threadIdx.x; asm volatile("" : "+v"(xb_tid_));
    if (xb_tid_ == 0) {
        unsigned* bar = b.bar;
        __builtin_amdgcn_s_waitcnt(0);
        unsigned nloc = b.st[0], nx = b.st[1];
        if (nloc == 0u) { xcd_barrier_complete(bar, b.x, nloc, nx); b.st[0] = nloc; b.st[1] = nx; }
        const unsigned old = xb_add(&bar[XB_XSUB(b.x)], 1u);
        const unsigned gen = old / nloc;
        if (old + 1u == (gen + 1u) * nloc) {
            __builtin_amdgcn_fence(__ATOMIC_RELEASE, "agent");
            asm volatile("s_waitcnt vmcnt(0)" ::: "memory");
            const unsigned og = xb_add(&bar[XB_TOP], 1u);
            const unsigned tg = og / nx;
            if (og + 1u == (tg + 1u) * nx) xb_add(&bar[XB_TOPGEN], 1u);
            else XB_SPIN(xb_ld(&bar[XB_TOPGEN]) == tg, bar);
            __builtin_amdgcn_fence(__ATOMIC_ACQUIRE, "agent");
            xb_add(&bar[XB_XGEN(b.x)], 1u);
            asm volatile("s_waitcnt vmcnt(0)" ::: "memory");
        } else {
            XB_SPIN(xb_ld(&bar[XB_XGEN(b.x)]) == gen, bar);
            __builtin_amdgcn_fence(__ATOMIC_ACQUIRE, "agent");
            asm volatile("s_waitcnt vmcnt(0)" ::: "memory");
        }
    }
    __syncthreads();
}

__device__ __forceinline__ void quad_barrier(const XcdBarrier& b) {
    asm volatile("s_waitcnt vmcnt(0)" ::: "memory");
    __syncthreads();
    int xb_tid_ = threadIdx.x; asm volatile("" : "+v"(xb_tid_));
    if (xb_tid_ == 0) {
        unsigned* bar = b.bar;
        __builtin_amdgcn_s_waitcnt(0);
        const unsigned q = (blockIdx.x & 7u) * 8u + ((blockIdx.x >> 3) & 7u); constexpr unsigned nloc = 4u;
        const unsigned old = xb_add(&bar[XB_QSUB(q)], 1u);
        const unsigned gen = old / nloc;
        if (old + 1u == (gen + 1u) * nloc) xb_add(&bar[XB_QGEN(q)], 1u);
        else XB_SPIN(xb_ld(&bar[XB_QGEN(q)]) == gen, bar);
        __builtin_amdgcn_fence(__ATOMIC_ACQUIRE, "agent");
        asm volatile("s_waitcnt vmcnt(0)" ::: "memory");
    }
    __syncthreads();
}

constexpr int NWAVES = 8;
constexpr int NCU_NOM = 256;
constexpr int DM = 2048, NB = 4, SEQ = 4096, DEPTH = 4, MTOK = NB * SEQ;
constexpr int DIN = 9216, FFH = 5632, NF13 = 2 * FFH, MODW = 6 * DM;
constexpr int PC_V = 1024, PC_G0 = 5120, PC_G1 = 7168;
constexpr float EPS = 1e-6f;
constexpr size_t MiB = 1u << 20;
constexpr size_t WS_CTL = 0, CTL_ZERO_BYTES = 1 * MiB;
constexpr size_t WS_MOD = 1 * MiB;
constexpr size_t WS_ROPE = 2 * MiB;
constexpr size_t WS_LAM = 3 * MiB;
constexpr size_t WS_WSB = 4 * MiB;
constexpr size_t WS_VSTAT = 5 * MiB;
constexpr size_t WS_WIN = 8 * MiB;
constexpr size_t WS_WUG = 152 * MiB;
constexpr size_t WS_WUA = 168 * MiB;
constexpr size_t WS_WO = 184 * MiB;
constexpr size_t WS_W13 = 216 * MiB;
constexpr size_t WS_W2 = 392 * MiB;
constexpr size_t WS_X = 480 * MiB;
constexpr size_t WS_H = 608 * MiB;
constexpr size_t WS_BRA = 672 * MiB;
constexpr size_t WS_BRB = 704 * MiB;
constexpr size_t WS_MG = 736 * MiB;
constexpr size_t WS_P = 800 * MiB;
constexpr size_t WS_QKV = 1088 * MiB;
constexpr size_t WS_D = 1184 * MiB;
constexpr size_t WS_T = 1312 * MiB;
constexpr size_t WS_END = 1488 * MiB;
constexpr int CW_TMO = 0, CW_CODE = 1, CW_BAR = 4096, CW_UV = 32768  , CW_GQ = 40960  ;
constexpr int RING_OFF = 0, RING_BYTES = 151552;
constexpr int LDSCTL_OFF = RING_BYTES, MISC_OFF = LDSCTL_OFF + 320;
constexpr int LDS_BYTES = 152576;
static_assert(att::SHM_ATTN <= RING_BYTES && att::GM_END <= RING_BYTES && MISC_OFF + 128 <= LDS_BYTES && LDS_BYTES <= 163840, "LDS map");

struct Frame {
    LAS unsigned char* lds;
    volatile LAS unsigned* MISC;
    gu32* ctl;
    int wave;
    int vcu, G;
};

__device__ __forceinline__ int fresh_tid() { int t = threadIdx.x; asm volatile("" : "+v"(t)); return t; }
__device__ __forceinline__ float wave_sum(float v) {
    v += __int_as_float(__builtin_amdgcn_ds_swizzle(__float_as_int(v), (1 << 10) | 0x1f));
    v += __int_as_float(__builtin_amdgcn_ds_swizzle(__float_as_int(v), (2 << 10) | 0x1f));
    v += __int_as_float(__builtin_amdgcn_ds_swizzle(__float_as_int(v), (4 << 10) | 0x1f));
    v += __int_as_float(__builtin_amdgcn_ds_swizzle(__float_as_int(v), (8 << 10) | 0x1f));
    v += __int_as_float(__builtin_amdgcn_ds_swizzle(__float_as_int(v), (16 << 10) | 0x1f));
    { auto rr = __builtin_amdgcn_permlane32_swap(__float_as_uint(v), __float_as_uint(v), false, false); v = __uint_as_float(rr[0]) + __uint_as_float(rr[1]); }
    return v;
}
__device__ __forceinline__ int dest_row(int n, int mode) {
    if (mode == 1) { if (n >= 2048 && n < 4096) { const int i = n & 63; return (n & ~63) + (i < 32 ? 2 * i : 2 * (i - 32) + 1); }
                     if (n >= 5120) { const int j = (n - 5120) & 2047, hi = (n - 5120) >> 11; return 5120 + (j >> 7) * 256 + hi * 128 + (j & 127); }
                     return n; }
    if (mode == 2) return (n >> 7) * 256 + (n & 127);
    if (mode == 3) return (n >> 7) * 256 + 128 + (n & 127);
    return n;
}
__device__ __forceinline__ void p0_transpose_item(const float* W, int K, int N, bf16* WT, int mode, LAS float* scr, int item, int lane, int ldk = 0, int koff = 0) {
    const int nblk = N / 32, kb = item / nblk, nb = item % nblk, k0 = 64 * kb, n0 = 32 * nb;
#pragma unroll 8
    for (int i = 0; i < 32; ++i) { const int kk = 2 * i + (lane >> 5); scr[kk * 33 + (lane & 31)] = __builtin_nontemporal_load(&W[(size_t)(k0 + kk) * N + n0 + (lane & 31)]); }
    LDS_WAIT(); asm volatile("" ::: "memory");
    const int c = lane & 7;
#pragma unroll
    for (int j = 0; j < 4; ++j) { const int n = (lane >> 3) + 8 * j; const LAS float* s = scr + (8 * c) * 33 + n;
        v4u o; o.x = pk2(s[0 * 33], s[1 * 33]); o.y = pk2(s[2 * 33], s[3 * 33]); o.z = pk2(s[4 * 33], s[5 * 33]); o.w = pk2(s[6 * 33], s[7 * 33]);
        *(GAS v4u*)(WT + (size_t)dest_row(n0 + n, mode) * (ldk ? ldk : K) + koff + k0 + 8 * c) = o; }
    LDS_WAIT(); asm volatile("" ::: "memory");
}

struct In {
    const float *x, *c, *ada_w, *ada_b, *norm1_g, *norm2_g, *w_in, *gmlp_ln_g, *gmlp_ln_b, *w_s, *b_s, *lq1, *lk1, *lq2, *lk2, *subln_g, *w_up_gmlp, *w_up_attn, *w_o, *ffn_w1, *ffn_w3, *ffn_w2, *final_g;
};
struct Args { In in; float* out; unsigned char* ws; };

__device__ __forceinline__ void p0_prologue(const Frame& F, const In& I, unsigned char* ws) {
    const int tid = fresh_tid(), lane = tid & 63;
    float* mod = (float*)(ws + WS_MOD);
    {
        constexpr int SW = 192, NSTRIP = MODW / SW;
        LAS float* cact = (LAS float*)(F.lds + RING_OFF);
        LAS float* red = (LAS float*)(F.lds + RING_OFF + 32768);
        bool have = false;
        for (int it = F.vcu; it < DEPTH * NSTRIP; it += F.G) {
            if (!have) { for (int i = tid; i < NB * DM; i += NWAVES * 64) { const float cv = I.c[i]; cact[i] = cv / (1.0f + expf(-cv)); } have = true; __syncthreads(); }
            const int l = it / NSTRIP, s = it % NSTRIP;
            f32x4 a0 = {0.f, 0.f, 0.f, 0.f}, a1 = a0, a2 = a0, a3 = a0;
            if (lane < SW / 4) {
                const float* wp = I.ada_w + ((size_t)l * DM + F.wave * 256) * MODW + s * SW + 4 * lane;
                const LAS float* cp = cact + F.wave * 256;
#pragma unroll 8
                for (int kk = 0; kk < 256; ++kk) { const f32x4 w = __builtin_nontemporal_load((const f32x4*)(wp + (size_t)kk * MODW));
                    a0 += w * cp[kk]; a1 += w * cp[DM + kk]; a2 += w * cp[2 * DM + kk]; a3 += w * cp[3 * DM + kk]; }
                *(LAS f32x4*)(red + (F.wave * NB + 0) * SW + 4 * lane) = a0; *(LAS f32x4*)(red + (F.wave * NB + 1) * SW + 4 * lane) = a1;
                *(LAS f32x4*)(red + (F.wave * NB + 2) * SW + 4 * lane) = a2; *(LAS f32x4*)(red + (F.wave * NB + 3) * SW + 4 * lane) = a3;
            }
            __syncthreads();
            for (int idx = tid; idx < NB * SW; idx += NWAVES * 64) { const int b = idx / SW, col = idx % SW; float sum = I.ada_b[(size_t)l * MODW + s * SW + col];
#pragma unroll
                for (int w = 0; w < 8; ++w) sum += red[(w * NB + b) * SW + col];
                mod[((size_t)l * NB + b) * MODW + s * SW + col] = sum; }
            __syncthreads();
        }
        __syncthreads();
    }
    const int gtid = F.vcu * (NWAVES * 64) + tid, NGT = F.G * NWAVES * 64;
    {
        float* rc = (float*)(ws + WS_ROPE); float* rs = rc + SEQ * 32;
        for (int idx = gtid; idx < SEQ * 32; idx += NGT) { const int pos = idx >> 5, i = idx & 31;
            const float invf = (float)exp2(-(double)i * (13.287712379549449 / 32.0));
            const float angf = (float)pos * invf; const double ang = (double)angf;
            const double kq = rint(ang * 0.63661977236758134); const double t = (ang - kq * 1.5707963267948966) - kq * 6.123233995736766e-17; const double t2 = t * t;
            const double sp = t * (1.0 + t2 * (-1.0 / 6 + t2 * (1.0 / 120 + t2 * (-1.0 / 5040 + t2 * (1.0 / 362880 + t2 * (-1.0 / 39916800))))));
            const double cp = 1.0 + t2 * (-0.5 + t2 * (1.0 / 24 + t2 * (-1.0 / 720 + t2 * (1.0 / 40320 + t2 * (-1.0 / 3628800 + t2 * (1.0 / 479001600))))));
            const int qd = ((int)kq) & 3; const double cv = qd == 0 ? cp : qd == 1 ? -sp : qd == 2 ? -cp : sp; const double sv = qd == 0 ? sp : qd == 1 ? cp : qd == 2 ? -sp : -cp;
            rc[idx] = (float)cv; rs[idx] = (float)sv; }
    }
    if (blockIdx.x == 0 && F.wave == 0) {
        for (int l = 0; l < DEPTH; ++l) { const float s1 = wave_sum(I.lq1[l * 64 + lane] * I.lk1[l * 64 + lane]), s2 = wave_sum(I.lq2[l * 64 + lane] * I.lk2[l * 64 + lane]);
            const float linit = 0.8f - 0.6f * expf(-0.3f * (float)l);
            if (lane == 0) ((float*)(ws + WS_LAM))[l] = expf(s1) - expf(s2) + linit; }
    }
    { bf16* wsb = (bf16*)(ws + WS_WSB);
        for (int i = gtid; i < DEPTH * 8 * 128 * 128 / 4; i += NGT) { const f32x4 v = *(const f32x4*)(I.w_s + (size_t)i * 4); unsigned long long o = (unsigned long long)pk2(v.x, v.y) | ((unsigned long long)pk2(v.z, v.w) << 32); *(GAS unsigned long long*)(wsb + (size_t)i * 4) = o; } }
    LAS float* scr = (LAS float*)(F.lds + RING_OFF + F.wave * 16384);
    const int gw = F.vcu * NWAVES + F.wave, NGW = F.G * NWAVES;
    constexpr int I_IN = (DM / 64) * (DIN / 32), I_UP = (1024 / 64) * (DM / 32), I_O = (DM / 64) * (DM / 32), I_F1 = (DM / 64) * (FFH / 32), I_F2 = (FFH / 64) * (DM / 32);
    constexpr int I_LAYER = I_IN + 2 * I_UP + I_O + 2 * I_F1 + I_F2;
    for (int it = gw; it < DEPTH * I_LAYER; it += NGW) {
        const int l = it / I_LAYER; int r = it % I_LAYER;
        if (r < I_IN) { p0_transpose_item(I.w_in + (size_t)l * DM * DIN, DM, DIN, (bf16*)(ws + WS_WIN) + (size_t)l * DIN * DM, 1, scr, r, lane); continue; } r -= I_IN;
        if (r < I_UP) { p0_transpose_item(I.w_up_gmlp + (size_t)l * 1024 * DM, 1024, DM, (bf16*)(ws + WS_WUG) + (size_t)l * DM * DM, 0, scr, r, lane, DM, 0); continue; } r -= I_UP;
        if (r < I_UP) { p0_transpose_item(I.w_up_attn + (size_t)l * 1024 * DM, 1024, DM, (bf16*)(ws + WS_WUG) + (size_t)l * DM * DM, 0, scr, r, lane, DM, 1024); continue; } r -= I_UP;
        if (r < I_O) { p0_transpose_item(I.w_o + (size_t)l * DM * DM, DM, DM, (bf16*)(ws + WS_WO) + (size_t)l * DM * DM, 0, scr, r, lane); continue; } r -= I_O;
        if (r < I_F1) { p0_transpose_item(I.ffn_w1 + (size_t)l * DM * FFH, DM, FFH, (bf16*)(ws + WS_W13) + (size_t)l * NF13 * DM, 2, scr, r, lane); continue; } r -= I_F1;
        if (r < I_F1) { p0_transpose_item(I.ffn_w3 + (size_t)l * DM * FFH, DM, FFH, (bf16*)(ws + WS_W13) + (size_t)l * NF13 * DM, 3, scr, r, lane); continue; } r -= I_F1;
        p0_transpose_item(I.ffn_w2 + (size_t)l * FFH * DM, FFH, DM, (bf16*)(ws + WS_W2) + (size_t)l * DM * FFH, 0, scr, r, lane);
    }
}

__device__ __forceinline__ void add_bf16x4(f32x4& v, unsigned long long d) { const unsigned lo = (unsigned)d, hi = (unsigned)(d >> 32);
    v.x += __uint_as_float(lo << 16); v.y += __uint_as_float(lo & 0xffff0000u); v.z += __uint_as_float(hi << 16); v.w += __uint_as_float(hi & 0xffff0000u); }
__device__ __forceinline__ void norm_mod_phase(const Frame& F0, const float* xin, const bf16* d1, const bf16* d2, float* xout, const float* g, const float* sh, const float* sc, bf16* H) {
    const Frame& F = F0; const int lane = fresh_tid() & 63;
    int wv_ = F.wave; asm volatile("" : "+s"(wv_));
    int vr_ = F.vcu; if (F.G == NCU_NOM) vr_ = (vr_ & ~31) + (vr_ & 7) * 4 + ((vr_ & 31) >> 3);
    const int gw = vr_ * NWAVES + wv_, NGW = F.G * NWAVES;
    for (int r0 = gw * 8; r0 < MTOK; r0 += NGW * 8) {
        const int b = r0 / SEQ; const float* shb = sh + (size_t)b * MODW + 4 * lane; const float* scb = sc + (size_t)b * MODW + 4 * lane;
        f32x4 cf[8], sv[8];
#pragma unroll
        for (int j = 0; j < 8; ++j) { const f32x4 g4 = *(const f32x4*)(g + 256 * j + 4 * lane), s4 = *(const f32x4*)(scb + 256 * j); cf[j] = g4 * (1.0f + s4); sv[j] = *(const f32x4*)(shb + 256 * j); }
#pragma unroll 2
        for (int i = 0; i < 8; ++i) {
            const GAS f32x4* xr = (const GAS f32x4*)(xin + (size_t)(r0 + i) * DM) + lane;
            f32x4 v[8]; float ss = 0.f;
#pragma unroll
            for (int j = 0; j < 8; ++j) v[j] = __builtin_nontemporal_load(&xr[64 * j]);
            if (d1) { const GAS unsigned long long* dr = (const GAS unsigned long long*)(d1 + (size_t)(r0 + i) * DM) + lane;
#pragma unroll
                for (int j = 0; j < 8; ++j) add_bf16x4(v[j], __builtin_nontemporal_load(&dr[64 * j])); }
            if (d2) { const GAS unsigned long long* dr = (const GAS unsigned long long*)(d2 + (size_t)(r0 + i) * DM) + lane;
#pragma unroll
                for (int j = 0; j < 8; ++j) add_bf16x4(v[j], __builtin_nontemporal_load(&dr[64 * j])); }
            if (xout) { GAS f32x4* xw = (GAS f32x4*)(xout + (size_t)(r0 + i) * DM) + lane;
#pragma unroll
                for (int j = 0; j < 8; ++j) __builtin_nontemporal_store(v[j], &xw[64 * j]); }
#pragma unroll
            for (int j = 0; j < 8; ++j) ss += (v[j].x * v[j].x + v[j].y * v[j].y) + (v[j].z * v[j].z + v[j].w * v[j].w);
            const float r = 1.0f / sqrtf(wave_sum(ss) * (1.0f / DM) + EPS);
            GAS unsigned long long* o8 = (GAS unsigned long long*)(H + (size_t)(r0 + i) * DM) + lane;
#pragma unroll
            for (int j = 0; j < 8; ++j) { const f32x4 y = v[j] * r * cf[j] + sv[j]; o8[64 * j] = (unsigned long long)pk2(y.x, y.y) | ((unsigned long long)pk2(y.z, y.w) << 32); }
        }
    }
}
__device__ __forceinline__ void final_norm_phase(const Frame& F, const float* x, const bf16* d1, const bf16* d2, const float* g, float* out, bool poison) {
    const int lane = fresh_tid() & 63;
    const int gw = F.vcu * NWAVES + F.wave, NGW = F.G * NWAVES; const float qn = __builtin_nanf("");
    f32x4 gv[8];
#pragma unroll
    for (int j = 0; j < 8; ++j) gv[j] = *(const f32x4*)(g + 256 * j + 4 * lane);
    for (int row = gw; row < MTOK; row += NGW) {
        const GAS f32x4* xr = (const GAS f32x4*)(x + (size_t)row * DM) + lane;
        const GAS unsigned long long* dr1 = (const GAS unsigned long long*)(d1 + (size_t)row * DM) + lane; const GAS unsigned long long* dr2 = (const GAS unsigned long long*)(d2 + (size_t)row * DM) + lane;
        f32x4 v[8]; float ss = 0.f;
#pragma unroll
        for (int j = 0; j < 8; ++j) { v[j] = __builtin_nontemporal_load(&xr[64 * j]); add_bf16x4(v[j], __builtin_nontemporal_load(&dr1[64 * j])); add_bf16x4(v[j], __builtin_nontemporal_load(&dr2[64 * j]));
            ss += (v[j].x * v[j].x + v[j].y * v[j].y) + (v[j].z * v[j].z + v[j].w * v[j].w); }
        const float r = 1.0f / sqrtf(wave_sum(ss) * (1.0f / DM) + EPS);
        GAS f32x4* o = (GAS f32x4*)(out + (size_t)row * DM) + lane;
#pragma unroll
        for (int j = 0; j < 8; ++j) { f32x4 y = v[j] * r * gv[j]; if (poison) y = (f32x4){qn, qn, qn, qn}; __builtin_nontemporal_store(y, &o[64 * j]); }
    }
}

#ifndef ATT_FN
#define ATT_FN attn_unit_d
#endif
#ifndef THIN_ALIGN
#define THIN_ALIGN true
#endif
__global__ void __launch_bounds__(NWAVES * 64, 2) mk_fwd(Args args) {
    extern __shared__ __attribute__((aligned(16))) unsigned char lds[];
    Frame F;
    F.lds = (LAS unsigned char*)lds;
    F.MISC = (volatile LAS unsigned*)(F.lds + MISC_OFF);
    F.wave = __builtin_amdgcn_readfirstlane(threadIdx.x >> 6);
    F.G = gridDim.x; { const int bx = blockIdx.x; F.vcu = (F.G % 8 == 0) ? (bx % 8) * (F.G / 8) + bx / 8 : bx; }
    unsigned char* ws = args.ws; const In& I = args.in;
    F.ctl = (gu32*)(ws + WS_CTL);
    for (int u = threadIdx.x; u < (LDS_BYTES - LDSCTL_OFF) / 4; u += NWAVES * 64) ((LAS unsigned*)(F.lds + LDSCTL_OFF))[u] = 0u;
    __syncthreads();
    XcdBarrier bar = xcd_barrier_post((unsigned*)(F.ctl + CW_BAR), F.MISC + 8);
#ifdef PROBE_MASK
    if (blockIdx.x == 0 && threadIdx.x == 0) ((LAS unsigned*)(F.lds + LDSCTL_OFF))[30] = (unsigned)rt();
#ifdef PROBE_CYC
    if (blockIdx.x == 0 && threadIdx.x == 0) ((LAS unsigned*)(F.lds + LDSCTL_OFF))[30] = (unsigned)__builtin_readcyclecounter();
#define STAMP(p) do { if (blockIdx.x == 0 && threadIdx.x == 0) { LAS unsigned* w_ = (LAS unsigned*)(F.lds + LDSCTL_OFF); const unsigned t_ = (unsigned)__builtin_readcyclecounter(); w_[p] += (t_ - w_[30]) / 24u; w_[30] = t_; } } while (0)
#else
#define STAMP(p) do { if (blockIdx.x == 0 && threadIdx.x == 0) { LAS unsigned* w_ = (LAS unsigned*)(F.lds + LDSCTL_OFF); const unsigned t_ = (unsigned)rt(); w_[p] += t_ - w_[30]; w_[30] = t_; } } while (0)
#endif
#else
#define STAMP(p) do { } while (0)
#endif
#define BAR_DO_(LOC) do { XcdBarrier b2_ = bar; asm volatile("" : "+s"(b2_.bar), "+s"(b2_.x)); \
    if ((LOC) && (unsigned)__builtin_amdgcn_readfirstlane((int)F.MISC[10]) == 2u) quad_barrier(b2_); else xcd_barrier(b2_); } while (0)
#ifdef PROBE_BWAIT
#define BAR_T_(LOC) do { unsigned long long tb_ = 0; if (blockIdx.x == PROBE_BLK && threadIdx.x == 0) tb_ = rt(); BAR_DO_(LOC); \
    if (blockIdx.x == PROBE_BLK && threadIdx.x == 0) { LAS unsigned* w_ = (LAS unsigned*)(F.lds + LDSCTL_OFF); const unsigned k_ = w_[27]; w_[27] = k_ + 1; const unsigned ty_ = k_ == 0 ? 0u : 1u + (k_ - 1u) % 8u; \
        if ((PROBE_BMASK >> ty_) & 1) w_[28] += (unsigned)(rt() - tb_); } } while (0)
#define GRID_BAR() BAR_T_(0)
#define LOCAL_BAR() BAR_T_(1)
#else
#define GRID_BAR() BAR_DO_(0)
#define LOCAL_BAR() BAR_DO_(1)
#endif

    float* const mod = (float*)(ws + WS_MOD);
    const float* const rcos = (const float*)(ws + WS_ROPE); const float* const rsin = rcos + SEQ * 32;
    float* const X = (float*)(ws + WS_X);
    bf16* const H = (bf16*)(ws + WS_H); bf16* const BRA = (bf16*)(ws + WS_BRA); bf16* const BRB = (bf16*)(ws + WS_BRA) + 1024;   bf16* const MG = (bf16*)(ws + WS_MG);
    bf16* const D1 = (bf16*)(ws + WS_D); bf16* const D2 = D1 + (size_t)MTOK * DM;
    bf16* const P = (bf16*)(ws + WS_P); bf16* const T = (bf16*)(ws + WS_T);
    pg8::f32x2* const vstat = (pg8::f32x2*)(ws + WS_VSTAT);

#ifndef PHM
#define PHM 0xFFFFF
#endif
#ifdef PROBE_IDLE
    { if (threadIdx.x == 0) { const unsigned long long t0_ = rt(); while (rt() - t0_ < (unsigned long long)PROBE_IDLE) __builtin_amdgcn_s_sleep(32); } __syncthreads(); }
#endif
    if constexpr (PHM & 1) p0_prologue(F, I, ws);
    GRID_BAR();
    if (threadIdx.x == 0) F.MISC[10] = (xb_ld((unsigned*)(F.ctl + CW_BAR) + XB_NONLOC) == 0u) ? 2u : 1u;
    __syncthreads();
    STAMP(0);

    for (int l = 0; l < DEPTH; ++l) {
        const float* modl = mod + (size_t)l * NB * MODW;
        const float* xin = (l == 0) ? I.x : X;
        const float* xprev = (l <= 1) ? I.x : X;
        if constexpr (PHM & 2) norm_mod_phase(F, (l == 0) ? xin : xprev, (l == 0) ? (const bf16*)nullptr : (const bf16*)D1, (l == 0) ? (const bf16*)nullptr : (const bf16*)D2, (l == 0) ? (float*)nullptr : X, I.norm1_g + (size_t)l * DM, modl + 0 * DM, modl + 1 * DM, H);
        LOCAL_BAR();
        STAMP(1);
        if constexpr (PHM & 4) { pg8::Gemm g{H, (const bf16*)(ws + WS_WIN) + (size_t)l * DIN * DM, MTOK, DIN, DM}; pg8::UvOrder S; S.init(MTOK, DIN, F.G, (int)blockIdx.x); S.cnt = (unsigned*)(F.ctl + CW_UV);
          pg8::EpiIn E{P, (bf16*)(ws + WS_QKV), rcos, rsin, vstat};
          pg8::gemm_phase<pg8::EpiIn, pg8::UvOrder, true, true>(F.lds + RING_OFF, g, S, E); }
        if constexpr (PHM & 0x2000) {
            volatile LAS unsigned* const gqw = (volatile LAS unsigned*)(F.lds + LDSCTL_OFF) + 24;
            unsigned* const gq = (unsigned*)(F.ctl + CW_GQ) + 64 * l; unsigned* const uvc = (unsigned*)(F.ctl + CW_UV); const unsigned need = 64u * (unsigned)(l + 1);
            int t0_ = threadIdx.x; asm volatile("" : "+v"(t0_));
            __syncthreads();
            if (t0_ == 0) { unsigned ok = 1u;
                for (int mt = 0; mt < MTOK / 256; ++mt) ok &= (xb_ld(uvc + 64 * mt) >= need) ? 1u : 0u;
                if (!ok) for (int mt = 0; mt < MTOK / 256; ++mt) XB_SPIN(xb_ld(uvc + 64 * mt) < need, (unsigned*)(F.ctl + CW_BAR));
                __builtin_amdgcn_fence(__ATOMIC_ACQUIRE, "agent"); asm volatile("s_waitcnt vmcnt(0)" ::: "memory");
                gqw[0] = xb_add(gq, 1u); }
            __syncthreads();
            { const int gu0 = __builtin_amdgcn_readfirstlane((int)gqw[0]);
              __syncthreads();
              att::gmlp_units<true>(P, BRA, (const att::f32x2v*)vstat, (const bf16*)(ws + WS_WSB) + (size_t)l * 8 * 128 * 128, I.b_s + (size_t)l * 8 * 128, I.gmlp_ln_g + (size_t)l * 1024, I.gmlp_ln_b + (size_t)l * 1024,
                                     gu0, 0, NB * (SEQ / 128) * 8, (LAS char*)(F.lds + RING_OFF), gq, gqw); }
            __syncthreads();
        }
        GRID_BAR();
        STAMP(2);
        if constexpr (PHM & 8) { const float lam = __uint_as_float((unsigned)__builtin_amdgcn_readfirstlane((int)__float_as_uint(((const float*)(ws + WS_LAM))[l]))); const float oml = __uint_as_float((unsigned)__builtin_amdgcn_readfirstlane((int)__float_as_uint(1.0f - (0.8f - 0.6f * expf(-0.3f * (float)l)))));
          const bf16* const qkv = (const bf16*)(ws + WS_QKV); const float* const sg = I.subln_g + (size_t)l * 128;
          unsigned redo = 0u; int ui = 0;
          int vc_ = F.vcu; asm volatile("" : "+s"(vc_));
          if constexpr (PHM & 0x1000) for (int u = vc_; u < NB * 8 * (SEQ / 128); u += F.G, ++ui) { const int bh = u >> 5, qb = u & 31;
              if (att::ATT_FN<true>(qkv, BRB, bh >> 3, bh & 7, qb, lam, oml, sg, (LAS char*)(F.lds + RING_OFF))) redo |= 1u << (ui & 31); __syncthreads(); }
          if (redo != 0u) { ui = 0;
              for (int u = F.vcu; u < NB * 8 * (SEQ / 128); u += F.G, ++ui) if ((redo >> (ui & 31)) & 1u) { const int bh = u >> 5, qb = u & 31;
                  (void)att::ATT_FN<false>(qkv, BRB, bh >> 3, bh & 7, qb, lam, oml, sg, (LAS char*)(F.lds + RING_OFF)); __syncthreads(); } }
          STAMP(3); }
        GRID_BAR();
        STAMP(10);
        if constexpr (PHM & 16) { pg8::Gemm g{BRA, (const bf16*)(ws + WS_WUG) + (size_t)l * DM * DM, MTOK, DM, DM}; pg8::StaticOrder S; S.init(MTOK, DM, F.G, (int)blockIdx.x);
          pg8::EpiUpCat E{MG, P, PC_G0, PC_G1};
          pg8::gemm_phase<pg8::EpiUpCat, pg8::StaticOrder, THIN_ALIGN, true>(F.lds + RING_OFF, g, S, E); }
        LOCAL_BAR();
        STAMP(4);
        if constexpr (PHM & 64) { pg8::Gemm g{MG, (const bf16*)(ws + WS_WO) + (size_t)l * DM * DM, MTOK, DM, DM}; pg8::StaticOrder S; S.init(MTOK, DM, F.G, (int)blockIdx.x);
          pg8::EpiDelta E{D1, modl + 2 * DM, MODW};
          pg8::gemm_phase<pg8::EpiDelta, pg8::StaticOrder, THIN_ALIGN, true>(F.lds + RING_OFF, g, S, E); }
        LOCAL_BAR();
        STAMP(5);
        if constexpr (PHM & 128) norm_mod_phase(F, xin, D1, (const bf16*)nullptr, (float*)nullptr, I.norm2_g + (size_t)l * DM, modl + 3 * DM, modl + 4 * DM, H);
        LOCAL_BAR();
        STAMP(6);
        if constexpr (PHM & 256) { pg8::Gemm g{H, (const bf16*)(ws + WS_W13) + (size_t)l * NF13 * DM, MTOK, NF13, DM}; pg8::StaticOrder S; S.init(MTOK, NF13, F.G, (int)blockIdx.x);
          pg8::EpiSwiglu E{T};
          pg8::gemm_phase<pg8::EpiSwiglu, pg8::StaticOrder, true, true>(F.lds + RING_OFF, g, S, E); }
        LOCAL_BAR();
        STAMP(7);
        if constexpr (PHM & 512) { pg8::Gemm g{T, (const bf16*)(ws + WS_W2) + (size_t)l * DM * FFH, MTOK, DM, FFH}; pg8::StaticOrder S; S.init(MTOK, DM, F.G, (int)blockIdx.x);
          pg8::EpiDelta E{D2, modl + 5 * DM, MODW};
          pg8::gemm_phase<pg8::EpiDelta, pg8::StaticOrder, THIN_ALIGN, true>(F.lds + RING_OFF, g, S, E); }
        if (l == DEPTH - 1) GRID_BAR(); else LOCAL_BAR();
        STAMP(8);
    }
    { const bool poison = (__hip_atomic_load((gu32*)((unsigned*)(F.ctl + CW_BAR) + XB_TMO), RLX_AGENT) != 0u) || (__hip_atomic_load(F.ctl + CW_TMO, RLX_AGENT) != 0u);
      final_norm_phase(F, (DEPTH <= 1) ? I.x : X, D1, D2, I.final_g, args.out, poison); }
#ifdef PROBE_BWAIT
    if (blockIdx.x == PROBE_BLK && threadIdx.x == 0) { unsigned long long tot = ((LAS unsigned*)(F.lds + LDSCTL_OFF))[28]; tot *= PROBE_MUL; const unsigned long long t0 = rt(); while (rt() - t0 < tot) __builtin_amdgcn_s_sleep(16); }
#endif
#ifdef PROBE_MASK
    STAMP(9);
    if (blockIdx.x == 0 && threadIdx.x == 0) { unsigned long long tot = 0; for (int p = 0; p < 16; ++p) if ((PROBE_MASK >> p) & 1) tot += ((LAS unsigned*)(F.lds + LDSCTL_OFF))[p];
        tot *= PROBE_MUL; const unsigned long long t0 = rt(); while (rt() - t0 < tot) __builtin_amdgcn_s_sleep(16); }
#endif
#undef GRID_BAR
}

extern "C" void kernel_launch(void* const* d_in, const int* in_sizes, int n_in, void* d_out, int out_size, void* d_ws, size_t ws_size, hipStream_t stream) {
    static int grid = 0;
    if (grid == 0) {
        if (n_in != 23 || in_sizes[0] != MTOK * DM || out_size != MTOK * DM || ws_size < WS_END) { fprintf(stderr, "kernel_launch: unexpected shapes: n_in %d in0 %d out %d ws %zu (need %zu)\n", n_in, n_in > 0 ? in_sizes[0] : -1, out_size, ws_size, (size_t)WS_END); grid = -1; return; }
        int dev = 0, cus = 0, per_cu = 0;
        if (hipGetDevice(&dev) != hipSuccess || hipDeviceGetAttribute(&cus, hipDeviceAttributeMultiprocessorCount, dev) != hipSuccess) { fprintf(stderr, "kernel_launch: device query failed\n"); grid = -1; return; }
        if (hipFuncSetAttribute((const void*)mk_fwd, hipFuncAttributeMaxDynamicSharedMemorySize, LDS_BYTES) != hipSuccess) { fprintf(stderr, "kernel_launch: hipFuncSetAttribute failed\n"); grid = -1; return; }
        if (hipOccupancyMaxActiveBlocksPerMultiprocessor(&per_cu, (const void*)mk_fwd, NWAVES * 64, LDS_BYTES) != hipSuccess || per_cu < 1) { fprintf(stderr, "kernel_launch: occupancy query reports %d blocks per CU\n", per_cu); }
        (void)hipGetLastError();
        grid = cus;
    }
    if (grid < 0) return;
    if (hipMemsetAsync((char*)d_ws + WS_CTL, 0, CTL_ZERO_BYTES, stream) != hipSuccess) { fprintf(stderr, "kernel_launch: memset failed\n"); return; }
    Args a{};
    const float** ip = (const float**)&a.in;
    for (int i = 0; i < 23; ++i) ip[i] = (const float*)d_in[i];
    a.out = (float*)d_out; a.ws = (unsigned char*)d_ws;
    hipLaunchKernelGGL(mk_fwd, dim3(grid), dim3(NWAVES * 64), LDS_BYTES, stream, a);
    const hipError_t le = hipPeekAtLastError();
    if (le != hipSuccess) fprintf(stderr, "kernel_launch: launch failed: %s\n", hipGetErrorName(le));
}
```

```cpp
#include <hip/hip_runtime.h>
#include <hip/hip_bf16.h>
#include <cstdio>
#include <cstdint>
#include <cmath>
#ifdef PROBE_MASK
#define ATT_STAMP_BASE 151552
#define ATT_STAMP0() do { if (blockIdx.x == 0 && threadIdx.x == 0) ((__attribute__((address_space(3))) unsigned*)((__attribute__((address_space(3))) char*)lds + ATT_STAMP_BASE))[31] = (unsigned)__builtin_amdgcn_s_memrealtime(); } while (0)
#define ATT_STAMP(p) do { if (blockIdx.x == 0 && threadIdx.x == 0) { __attribute__((address_space(3))) unsigned* w__ = (__attribute__((address_space(3))) unsigned*)((__attribute__((address_space(3))) char*)lds + ATT_STAMP_BASE); const unsigned t__ = (unsigned)__builtin_amdgcn_s_memrealtime(); w__[p] += t__ - w__[31]; w__[31] = t__; } } while (0)
#else
#define ATT_STAMP0() do { } while (0)
#define ATT_STAMP(p) do { } while (0)
#endif
namespace pg8 {
#define PG8_LAS __attribute__((address_space(3)))
typedef unsigned short bf16_t;
typedef short bf16x8 __attribute__((ext_vector_type(8)));
typedef float f32x4 __attribute__((ext_vector_type(4)));
typedef unsigned u32x4 __attribute__((ext_vector_type(4)));
constexpr int BM = 256, BK = 64, HALF = 128, HTB = HALF * BK * 2  , STAGE_BYTES = 8 * HTB, NXCD = 8, WGM = 8;

__host__ __device__ __forceinline__ int lds_byte(int r, int c) { const int st = (r >> 4) * 2 + (c >> 5), rr = r & 15, cc = c & 31, ob = rr * 64 + cc * 2; return st * 1024 + (ob ^ (((ob >> 9) & 1) << 5)); }
__host__ __device__ __forceinline__ void stage_rc(int b, int& R, int& C) { const int st = b / 1024, sb = b % 1024, swz = sb ^ (((sb >> 9) & 1) << 5); R = (st >> 1) * 16 + swz / 64; C = (st & 1) * 32 + (swz % 64) / 2; }
__host__ __device__ __forceinline__ int perm32(int rho) { const int n = rho >> 4, i = rho & 15; return 8 * (i >> 2) + 4 * n + (i & 3); }

struct Unit { int pm, pn; };
struct Gemm { const bf16_t* A; const bf16_t* Bt; int M, N, K; };

struct StaticOrder {
    int nM, nN, nwg, G, c;
    __host__ __device__ void init(int M, int N, int G_, int c_) { nM = M / BM; nN = N / BM; nwg = nM * nN; G = G_; c = c_; }
    __host__ __device__ bool next(int i, Unit& u) const {
        const long L = (long)i * G + c; if (L >= nwg) return false;
        int wgid = (int)L; { const int q = nwg / NXCD, r = nwg % NXCD, xcd = wgid % NXCD, off = wgid / NXCD; wgid = (xcd < r ? xcd * (q + 1) : r * (q + 1) + (xcd - r) * q) + off; }
        const int nig = WGM * nN, gid = wgid / nig, fm = gid * WGM, gsz = (nM - fm) < WGM ? (nM - fm) : WGM;
        u.pm = fm + ((wgid % nig) % gsz); u.pn = (wgid % nig) / gsz; return true;
    }
    __device__ __forceinline__ void a_ready(const Unit&) const {}
    __device__ __forceinline__ void done(const Unit&) const {}
};

struct UvOrder : StaticOrder {
    unsigned* cnt;
    __device__ __forceinline__ void done(const Unit& u) const {
        if (u.pn < 8) { asm volatile("s_waitcnt vmcnt(0)" ::: "memory");
            if (__builtin_amdgcn_mbcnt_hi(~0u, __builtin_amdgcn_mbcnt_lo(~0u, 0u)) == 0u) (void)__hip_atomic_fetch_add(cnt + 64 * (u.pm >> 3), 1u, __ATOMIC_RELAXED, __HIP_MEMORY_SCOPE_AGENT); }
    }
};

__device__ __forceinline__ unsigned cvt_pk_bf16(float lo, float hi) { unsigned r; asm volatile("v_cvt_pk_bf16_f32 %0, %1, %2" : "=v"(r) : "v"(lo), "v"(hi)); return r; }
typedef float f32x2 __attribute__((ext_vector_type(2)));
typedef unsigned u32x2 __attribute__((ext_vector_type(2)));
__device__ __forceinline__ float bf_lo(unsigned w) { return __uint_as_float(w << 16); }
__device__ __forceinline__ float bf_hi(unsigned w) { return __uint_as_float(w & 0xffff0000u); }
__device__ __forceinline__ float sigmoid_f(float x) { return __builtin_amdgcn_rcpf(1.0f + __builtin_amdgcn_exp2f(x * -1.4426950408889634f)); }
__device__ __forceinline__ float gelu_tanh_f(float x) { const float z = x * (1.5957691216057308f + 0.07135481627f * x * x); return x * sigmoid_f(z); }
__device__ __forceinline__ float silu_f(float x) { return x * sigmoid_f(x); }

#define ST16_WT(ptr, val) asm volatile("global_store_dwordx4 %0, %1, off sc1\n\ts_nop 1" :: "v"(ptr), "v"(val) : "memory")
#define ST8_WT(ptr, val)  asm volatile("global_store_dwordx2 %0, %1, off sc1\n\ts_nop 1" :: "v"(ptr), "v"(val) : "memory")
struct EpiIn {
    static constexpr bool PERM = true, AFTER_DRAIN = false, MIDK = false;
    bf16_t* P; bf16_t* QKV; const float* rcos; const float* rsin; f32x2* vstat;
    __device__ __forceinline__ void operator()(const f32x4 (&acc)[2][2][4][2], const Unit& u, int wr, int wc, int fr, int fq) const {
        const int pn = u.pn; const int row0 = u.pm * BM + wr * 64 + fr; const int colw = pn * BM + wc * 32 + 8 * fq;
        if (pn < 8) {
#pragma unroll
            for (int ai = 0; ai < 2; ++ai)
#pragma unroll
                for (int m = 0; m < 4; ++m) { const int row = row0 + ai * HALF + m * 16; bf16_t* rowp = P + (size_t)row * 9216 + colw;
                    float g[2][8];
#pragma unroll
                    for (int bj = 0; bj < 2; ++bj) {
#pragma unroll
                        for (int i = 0; i < 4; ++i) { g[bj][i] = gelu_tanh_f(acc[ai][bj][m][0][i]); g[bj][4 + i] = gelu_tanh_f(acc[ai][bj][m][1][i]); }
                        u32x4 w; w.x = cvt_pk_bf16(g[bj][0], g[bj][1]); w.y = cvt_pk_bf16(g[bj][2], g[bj][3]); w.z = cvt_pk_bf16(g[bj][4], g[bj][5]); w.w = cvt_pk_bf16(g[bj][6], g[bj][7]);
                        ST16_WT(rowp + bj * HALF, w); }
                    if (pn >= 4) {
                        float s = 0.f;
#pragma unroll
                        for (int bj = 0; bj < 2; ++bj)
#pragma unroll
                            for (int i = 0; i < 8; ++i) s += g[bj][i];
                        s += __shfl_xor(s, 16); s += __shfl_xor(s, 32);
                        const float mw = s * (1.0f / 64.0f); float q = 0.f;
#pragma unroll
                        for (int bj = 0; bj < 2; ++bj)
#pragma unroll
                            for (int i = 0; i < 8; ++i) { const float d = g[bj][i] - mw; q += d * d; }
                        q += __shfl_xor(q, 16); q += __shfl_xor(q, 32);
                        if (fq == 0) { const f32x2 st_ = {mw, q}; ST8_WT(&vstat[(size_t)row * 16 + (pn - 4) * 4 + wc], st_); }
                    } }
        } else if (pn < 16) {
#pragma unroll
            for (int ai = 0; ai < 2; ++ai)
#pragma unroll
                for (int m = 0; m < 4; ++m) { const int row = row0 + ai * HALF + m * 16; const int pos = row & 4095;
                    bf16_t* rowp = QKV + ((size_t)((pn - 8) >> 2) * 32 + (size_t)(row >> 12) * 8 + (size_t)((pn & 3) * 2)) * (4096 * 128) + (size_t)pos * 128 + wc * 32 + 8 * fq;
#pragma unroll
                    for (int bj = 0; bj < 2; ++bj) { const int pr0 = ((colw + bj * HALF) & 63) >> 1;
                        const f32x4 cs = *(const f32x4*)(rcos + pos * 32 + pr0), sn = *(const f32x4*)(rsin + pos * 32 + pr0);
                        const float qs = (pn < 12) ? 0.18033688011112042f : 1.0f;
                        const f32x4 v0 = acc[ai][bj][m][0] * qs, v1 = acc[ai][bj][m][1] * qs;
                        u32x4 w;
                        w.x = cvt_pk_bf16(v0[0] * cs[0] - v0[1] * sn[0], v0[1] * cs[0] + v0[0] * sn[0]);
                        w.y = cvt_pk_bf16(v0[2] * cs[1] - v0[3] * sn[1], v0[3] * cs[1] + v0[2] * sn[1]);
                        w.z = cvt_pk_bf16(v1[0] * cs[2] - v1[1] * sn[2], v1[1] * cs[2] + v1[0] * sn[2]);
                        w.w = cvt_pk_bf16(v1[2] * cs[3] - v1[3] * sn[3], v1[3] * cs[3] + v1[2] * sn[3]);
                        *(u32x4*)(rowp + (size_t)bj * (4096 * 128)) = w; } }
        } else if (pn < 20) {
#pragma unroll
            for (int ai = 0; ai < 2; ++ai)
#pragma unroll
                for (int m = 0; m < 4; ++m) { const int row = row0 + ai * HALF + m * 16;
                    bf16_t* rowp = QKV + ((size_t)64 + (size_t)(row >> 12) * 8 + (size_t)((pn & 3) * 2)) * (4096 * 128) + (size_t)(row & 4095) * 128 + wc * 32 + 8 * fq;
#pragma unroll
                    for (int bj = 0; bj < 2; ++bj) { const f32x4 v0 = acc[ai][bj][m][0], v1 = acc[ai][bj][m][1];
                        u32x4 w; w.x = cvt_pk_bf16(v0[0], v0[1]); w.y = cvt_pk_bf16(v0[2], v0[3]); w.z = cvt_pk_bf16(v1[0], v1[1]); w.w = cvt_pk_bf16(v1[2], v1[3]);
                        *(u32x4*)(rowp + (size_t)bj * (4096 * 128)) = w; } }
        } else {
            const int cg = (pn - 20) * HALF + wc * 32 + 8 * fq;
#pragma unroll
            for (int ai = 0; ai < 2; ++ai)
#pragma unroll
                for (int m = 0; m < 4; ++m) { bf16_t* rowp = P + (size_t)(row0 + ai * HALF + m * 16) * 9216 + cg;
                    float rr[8], g1[8];
#pragma unroll
                    for (int i = 0; i < 4; ++i) {
                        const float e0a = __builtin_amdgcn_exp2f(acc[ai][0][m][0][i] * -1.4426950408889634f), e1a = __builtin_amdgcn_exp2f(acc[ai][1][m][0][i] * -1.4426950408889634f);
                        const float e0b = __builtin_amdgcn_exp2f(acc[ai][0][m][1][i] * -1.4426950408889634f), e1b = __builtin_amdgcn_exp2f(acc[ai][1][m][1][i] * -1.4426950408889634f);
                        g1[i] = __builtin_amdgcn_rcpf(1.0f + e1a); rr[i] = (1.0f + e1a) * __builtin_amdgcn_rcpf(1.0f + e0a);
                        g1[4 + i] = __builtin_amdgcn_rcpf(1.0f + e1b); rr[4 + i] = (1.0f + e1b) * __builtin_amdgcn_rcpf(1.0f + e0b); }
                    u32x4 w; w.x = cvt_pk_bf16(rr[0], rr[1]); w.y = cvt_pk_bf16(rr[2], rr[3]); w.z = cvt_pk_bf16(rr[4], rr[5]); w.w = cvt_pk_bf16(rr[6], rr[7]);
                    *(u32x4*)(rowp + 5120) = w;
                    w.x = cvt_pk_bf16(g1[0], g1[1]); w.y = cvt_pk_bf16(g1[2], g1[3]); w.z = cvt_pk_bf16(g1[4], g1[5]); w.w = cvt_pk_bf16(g1[6], g1[7]);
                    *(u32x4*)(rowp + 7168) = w; }
        }
    }
};

struct EpiUpCat {
    static constexpr bool PERM = true, AFTER_DRAIN = false, MIDK = true;
    bf16_t* MG; const bf16_t* P; int gcol0, gcol1;
    __device__ __forceinline__ void mid(f32x4 (&acc)[2][2][4][2], const Unit& u, int wr, int wc, int fr, int fq) const {
        int row0 = u.pm * BM + wr * 64 + fr; const int colw = u.pn * BM + wc * 32 + 8 * fq;
        asm volatile("" : "+v"(row0));
#pragma unroll
        for (int ai = 0; ai < 2; ++ai) {
            u32x4 ga[4][2];
#pragma unroll
            for (int m = 0; m < 4; ++m) { const bf16_t* grow = P + (size_t)(row0 + ai * HALF + m * 16) * 9216 + gcol0 + colw;
#pragma unroll
                for (int bj = 0; bj < 2; ++bj) ga[m][bj] = *(const u32x4*)(grow + bj * HALF); }
#pragma unroll
            for (int m = 0; m < 4; ++m)
#pragma unroll
                for (int bj = 0; bj < 2; ++bj) { const u32x4 a = ga[m][bj];
                    acc[ai][bj][m][0] *= (f32x4){bf_lo(a.x), bf_hi(a.x), bf_lo(a.y), bf_hi(a.y)}; acc[ai][bj][m][1] *= (f32x4){bf_lo(a.z), bf_hi(a.z), bf_lo(a.w), bf_hi(a.w)}; }
            asm volatile("" ::: "memory");
        }
    }
    __device__ __forceinline__ void operator()(const f32x4 (&acc)[2][2][4][2], const Unit& u, int wr, int wc, int fr, int fq) const {
        const int row0 = u.pm * BM + wr * 64 + fr; const int colw = u.pn * BM + wc * 32 + 8 * fq;
#pragma unroll
        for (int ai = 0; ai < 2; ++ai)
#pragma unroll
            for (int m = 0; m < 4; ++m) { const int row = row0 + ai * HALF + m * 16; bf16_t* mrow = MG + (size_t)row * 2048 + colw; const bf16_t* grow = P + (size_t)row * 9216 + gcol1 + colw;
#pragma unroll
                for (int bj = 0; bj < 2; ++bj) { const u32x4 gw = *(const u32x4*)(grow + bj * HALF);
                    const f32x4 v0 = acc[ai][bj][m][0], v1 = acc[ai][bj][m][1];
                    u32x4 w; w.x = cvt_pk_bf16(v0[0] * bf_lo(gw.x), v0[1] * bf_hi(gw.x)); w.y = cvt_pk_bf16(v0[2] * bf_lo(gw.y), v0[3] * bf_hi(gw.y));
                    w.z = cvt_pk_bf16(v1[0] * bf_lo(gw.z), v1[1] * bf_hi(gw.z)); w.w = cvt_pk_bf16(v1[2] * bf_lo(gw.w), v1[3] * bf_hi(gw.w));
                    *(u32x4*)(mrow + bj * HALF) = w; } }
    }
};

struct EpiDelta {
    static constexpr bool PERM = true, AFTER_DRAIN = false, MIDK = false;
    bf16_t* D; const float* gate; int gstride;
    __device__ __forceinline__ void operator()(const f32x4 (&acc)[2][2][4][2], const Unit& u, int wr, int wc, int fr, int fq) const {
        const int row0 = u.pm * BM + wr * 64 + fr; const int colw = u.pn * BM + wc * 32 + 8 * fq;
        const float* gb = gate + (size_t)((u.pm * BM) >> 12) * gstride + colw;
        f32x4 gv[2][2];
#pragma unroll
        for (int bj = 0; bj < 2; ++bj)
#pragma unroll
            for (int n = 0; n < 2; ++n) gv[bj][n] = *(const f32x4*)(gb + bj * HALF + n * 4);
#pragma unroll
        for (int ai = 0; ai < 2; ++ai)
#pragma unroll
            for (int m = 0; m < 4; ++m) { bf16_t* rowp = D + (size_t)(row0 + ai * HALF + m * 16) * 2048 + colw;
#pragma unroll
                for (int bj = 0; bj < 2; ++bj) { const f32x4 v0 = gv[bj][0] * acc[ai][bj][m][0], v1 = gv[bj][1] * acc[ai][bj][m][1];
                    u32x4 w; w.x = cvt_pk_bf16(v0[0], v0[1]); w.y = cvt_pk_bf16(v0[2], v0[3]); w.z = cvt_pk_bf16(v1[0], v1[1]); w.w = cvt_pk_bf16(v1[2], v1[3]);
                    *(u32x4*)(rowp + bj * HALF) = w; } }
    }
};

struct EpiSwiglu {
    static constexpr bool PERM = true, AFTER_DRAIN = false, MIDK = false;
    bf16_t* T;
    __device__ __forceinline__ void operator()(const f32x4 (&acc)[2][2][4][2], const Unit& u, int wr, int wc, int fr, int fq) const {
        const int row0 = u.pm * BM + wr * 64 + fr; const int colw = u.pn * HALF + wc * 32 + 8 * fq;
#pragma unroll
        for (int ai = 0; ai < 2; ++ai)
#pragma unroll
            for (int m = 0; m < 4; ++m) { bf16_t* rowp = T + (size_t)(row0 + ai * HALF + m * 16) * 5632 + colw;
                const f32x4 a0 = acc[ai][0][m][0], a1 = acc[ai][0][m][1], b0 = acc[ai][1][m][0], b1 = acc[ai][1][m][1];
                u32x4 w; w.x = cvt_pk_bf16(silu_f(a0[0]) * b0[0], silu_f(a0[1]) * b0[1]); w.y = cvt_pk_bf16(silu_f(a0[2]) * b0[2], silu_f(a0[3]) * b0[3]);
                w.z = cvt_pk_bf16(silu_f(a1[0]) * b1[0], silu_f(a1[1]) * b1[1]); w.w = cvt_pk_bf16(silu_f(a1[2]) * b1[2], silu_f(a1[3]) * b1[3]);
                *(u32x4*)rowp = w; }
    }
};
template <class Epi, class Sched, bool ALIGN_EPI = false, bool SP2 = false>
__device__ __forceinline__ void gemm_phase(PG8_LAS unsigned char* lds, const Gemm g, const Sched& S, const Epi& E) {
    int tid_ = threadIdx.x; asm volatile("" : "+v"(tid_));
    const int tid = tid_, wid = __builtin_amdgcn_readfirstlane(tid >> 6), lane = tid & 63, wr = wid >> 2, wc = wid & 3, fr = lane & 15, fq = lane >> 4;
    const int K = g.K, nt = K / BK;
    unsigned voffA[2], voffB[2];
#pragma unroll
    for (int i = 0; i < 2; ++i) { int R, C; stage_rc(tid * 16 + i * 8192, R, C); const int Rb = Epi::PERM ? ((R & ~31) + perm32(R & 31)) : R;
        voffA[i] = (unsigned)(R * K + C) * 2u; voffB[i] = (unsigned)(Rb * K + C) * 2u; }
    const size_t kstep = (size_t)(BK * 2);
    const size_t hstep = (size_t)HALF * K * 2;
    const size_t tstep = 2 * hstep;
    const unsigned ldsw = (unsigned)wid * 1024u;
    const unsigned ldsb = (unsigned)__builtin_amdgcn_readfirstlane((int)((unsigned)(uintptr_t)lds + ldsw));
    const int aoff = lds_byte(wr * 64 + fr, fq * 8), boff = lds_byte(wc * 32 + fr, fq * 8);
#define PG8_SA(b, h) (((b) * 2 + (h)) * HTB)
#define PG8_SB(b, h) ((4 + (b) * 2 + (h)) * HTB)
#define PG8_GLDS(vo_, gb_, lo_) asm volatile("s_add_i32 m0, %2, %3\n\tglobal_load_lds_dwordx4 %0, %1" :: "v"(vo_), "s"(gb_), "s"(ldsb), "n"(lo_) : "memory", "m0", "scc")
#define PG8_STAGE(bufoff, gbase, voff) do { const char* gb__ = (const char*)(gbase); PG8_GLDS((voff)[0], gb__, (bufoff)); PG8_GLDS((voff)[1], gb__, (bufoff) + 8192); } while (0)
#define PG8_LDA(dst, b, h) do { _Pragma("unroll") for (int m = 0; m < 4; ++m) _Pragma("unroll") for (int k = 0; k < 2; ++k) dst[m][k] = *(const PG8_LAS bf16x8*)(lds + PG8_SA(b, h) + aoff + m * 2048 + k * 1024); } while (0)
#define PG8_LDB(dst, b, h) do { _Pragma("unroll") for (int n = 0; n < 2; ++n) _Pragma("unroll") for (int k = 0; k < 2; ++k) dst[n][k] = *(const PG8_LAS bf16x8*)(lds + PG8_SB(b, h) + boff + n * 2048 + k * 1024); } while (0)
#define PG8_MMA(ai, bj, At, Bt) do { __builtin_amdgcn_s_setprio(1); _Pragma("unroll") for (int m = 0; m < 4; ++m) _Pragma("unroll") for (int n = 0; n < 2; ++n) _Pragma("unroll") for (int k = 0; k < 2; ++k) \
        acc[ai][bj][m][n] = __builtin_amdgcn_mfma_f32_16x16x32_bf16(Bt[n][k], At[m][k], acc[ai][bj][m][n], 0, 0, 0); __builtin_amdgcn_s_setprio(0); } while (0)
#define PG8_MMA_NP(ai, bj, At, Bt) do { _Pragma("unroll") for (int m = 0; m < 4; ++m) _Pragma("unroll") for (int n = 0; n < 2; ++n) _Pragma("unroll") for (int k = 0; k < 2; ++k) \
        acc[ai][bj][m][n] = __builtin_amdgcn_mfma_f32_16x16x32_bf16(Bt[n][k], At[m][k], acc[ai][bj][m][n], 0, 0, 0); } while (0)
#define PG8_MMA2(ai, At, B0_, B1_) do { __builtin_amdgcn_s_setprio(1); PG8_MMA_NP(ai, 0, At, B0_); PG8_MMA_NP(ai, 1, At, B1_); __builtin_amdgcn_s_setprio(0); } while (0)
#define PG8_WAIT_V(n) asm volatile("s_waitcnt vmcnt(" #n ")" ::: "memory")
#define PG8_WAIT_L(n) asm volatile("s_waitcnt lgkmcnt(" #n ")" ::: "memory")
#define PG8_BAR __builtin_amdgcn_s_barrier()
#define PG8_SCHED __builtin_amdgcn_sched_barrier(0)
    Unit cur, nxt; int ui = 0;
    if (!S.next(0, cur)) return;
    f32x4 acc[2][2][4][2];
#pragma unroll
    for (int a = 0; a < 2; ++a)
#pragma unroll
        for (int b = 0; b < 2; ++b)
#pragma unroll
            for (int m = 0; m < 4; ++m)
#pragma unroll
                for (int n = 0; n < 2; ++n) acc[a][b][m][n] = (f32x4){0.f, 0.f, 0.f, 0.f};
    bf16x8 At[4][2], B0[2][2], B1[2][2];
    const char* cA = (const char*)g.A + (size_t)cur.pm * tstep; const char* cB = (const char*)g.Bt + (size_t)cur.pn * tstep;
    S.a_ready(cur);
    if constexpr (SP2) {
        PG8_STAGE(PG8_SB(0, 0), cB, voffB); PG8_STAGE(PG8_SB(0, 1), cB + hstep, voffB); PG8_STAGE(PG8_SA(0, 0), cA, voffA); PG8_STAGE(PG8_SA(0, 1), cA + hstep, voffA);
        if (wr == 1) PG8_BAR;
        PG8_WAIT_V(2); PG8_BAR;
        PG8_STAGE(PG8_SB(1, 0), cB + kstep, voffB); PG8_STAGE(PG8_SA(1, 0), cA + kstep, voffA); PG8_STAGE(PG8_SB(1, 1), cB + hstep + kstep, voffB);
        PG8_WAIT_V(6); PG8_BAR;
    } else {
        PG8_STAGE(PG8_SB(0, 0), cB, voffB); PG8_STAGE(PG8_SA(0, 0), cA, voffA); PG8_STAGE(PG8_SB(0, 1), cB + hstep, voffB); PG8_STAGE(PG8_SA(0, 1), cA + hstep, voffA);
        if (wr == 1) PG8_BAR;
        PG8_WAIT_V(4); PG8_BAR;
        PG8_STAGE(PG8_SB(1, 0), cB + kstep, voffB); PG8_STAGE(PG8_SA(1, 0), cA + kstep, voffA); PG8_STAGE(PG8_SB(1, 1), cB + hstep + kstep, voffB);
        PG8_WAIT_V(6); PG8_BAR;
    }
    for (;;) {
        const bool has_next = S.next(ui + 1, nxt);
        const char* nA = has_next ? (const char*)g.A + (size_t)nxt.pm * tstep : cA; const char* nB = has_next ? (const char*)g.Bt + (size_t)nxt.pn * tstep : cB;
        for (int t = 0; t < nt; t += 2) {
            const bool last = (t == nt - 2);
            const char* a1 = cA + (size_t)(t + 1) * kstep;
            const char* a2 = last ? nA : cA + (size_t)(t + 2) * kstep; const char* b2 = last ? nB : cB + (size_t)(t + 2) * kstep;
            const char* a3 = a2 + kstep; const char* b3 = b2 + kstep;
            if (last && has_next) S.a_ready(nxt);
            if constexpr (Epi::MIDK) { if (t == nt / 2) E.mid(acc, cur, wr, wc, fr, fq); }
            if constexpr (SP2) {
            PG8_LDB(B0, 0, 0); PG8_LDB(B1, 0, 1); PG8_SCHED; PG8_LDA(At, 0, 0); PG8_STAGE(PG8_SA(1, 1), a1 + hstep, voffA);
            PG8_WAIT_V(8); PG8_WAIT_L(0); PG8_BAR; PG8_MMA2(0, At, B0, B1); PG8_BAR; PG8_SCHED;
            PG8_LDA(At, 0, 1); PG8_STAGE(PG8_SB(0, 0), b2, voffB); PG8_STAGE(PG8_SB(0, 1), b2 + hstep, voffB); PG8_STAGE(PG8_SA(0, 0), a2, voffA);
            PG8_WAIT_V(8); PG8_WAIT_L(0); PG8_BAR; PG8_MMA2(1, At, B0, B1); PG8_BAR; PG8_SCHED;
            PG8_LDB(B0, 1, 0); PG8_LDB(B1, 1, 1); PG8_SCHED; PG8_LDA(At, 1, 0); PG8_STAGE(PG8_SA(0, 1), a2 + hstep, voffA);
            PG8_WAIT_V(8); PG8_WAIT_L(0); PG8_BAR; PG8_MMA2(0, At, B0, B1); PG8_BAR; PG8_SCHED;
            PG8_LDA(At, 1, 1); PG8_STAGE(PG8_SB(1, 0), b3, voffB); PG8_STAGE(PG8_SB(1, 1), b3 + hstep, voffB); PG8_STAGE(PG8_SA(1, 0), a3, voffA);
            PG8_WAIT_V(8); PG8_WAIT_L(0); PG8_BAR; PG8_MMA2(1, At, B0, B1); PG8_BAR; PG8_SCHED;
            } else {
            PG8_LDB(B0, 0, 0); PG8_SCHED; PG8_LDA(At, 0, 0); PG8_STAGE(PG8_SA(1, 1), a1 + hstep, voffA);
            PG8_WAIT_L(8); PG8_BAR; PG8_WAIT_L(0); PG8_MMA(0, 0, At, B0); PG8_BAR; PG8_SCHED;
            PG8_LDB(B1, 0, 1); PG8_STAGE(PG8_SB(0, 0), b2, voffB);
            PG8_BAR; PG8_WAIT_L(0); PG8_MMA(0, 1, At, B1); PG8_BAR;
            PG8_LDA(At, 0, 1); PG8_STAGE(PG8_SA(0, 0), a2, voffA);
            PG8_BAR; PG8_WAIT_L(0); PG8_MMA(1, 0, At, B0); PG8_BAR; PG8_SCHED;
            PG8_STAGE(PG8_SB(0, 1), b2 + hstep, voffB);
            PG8_WAIT_V(6); PG8_BAR; PG8_MMA(1, 1, At, B1); PG8_BAR;
            PG8_LDB(B0, 1, 0); PG8_SCHED; PG8_LDA(At, 1, 0); PG8_STAGE(PG8_SA(0, 1), a2 + hstep, voffA);
            PG8_WAIT_L(8); PG8_BAR; PG8_WAIT_L(0); PG8_MMA(0, 0, At, B0); PG8_BAR; PG8_SCHED;
            PG8_LDB(B1, 1, 1); PG8_STAGE(PG8_SB(1, 0), b3, voffB);
            PG8_BAR; PG8_WAIT_L(0); PG8_MMA(0, 1, At, B1); PG8_BAR;
            PG8_LDA(At, 1, 1); PG8_STAGE(PG8_SA(1, 0), a3, voffA);
            PG8_BAR; PG8_WAIT_L(0); PG8_MMA(1, 0, At, B0); PG8_BAR; PG8_SCHED;
            PG8_STAGE(PG8_SB(1, 1), b3 + hstep, voffB);
            PG8_WAIT_V(6); PG8_BAR; PG8_MMA(1, 1, At, B1); PG8_BAR;
            }
        }
        if constexpr (ALIGN_EPI) { if (wr == 0) PG8_BAR; }
        if constexpr (!Epi::AFTER_DRAIN) { E(acc, cur, wr, wc, fr, fq); S.done(cur); }
        if (!has_next) break;
#pragma unroll
        for (int a = 0; a < 2; ++a)
#pragma unroll
            for (int b = 0; b < 2; ++b)
#pragma unroll
                for (int m = 0; m < 4; ++m)
#pragma unroll
                    for (int n = 0; n < 2; ++n) acc[a][b][m][n] = (f32x4){0.f, 0.f, 0.f, 0.f};
        cur = nxt; cA = nA; cB = nB; ++ui;
        if constexpr (ALIGN_EPI) { if (wr == 1) PG8_BAR; }
    }
    PG8_WAIT_V(0);
    if constexpr (!ALIGN_EPI) { if (wr == 0) PG8_BAR; }
    PG8_BAR;
    if constexpr (Epi::AFTER_DRAIN) { E.fused(acc, cur, wr, wc, fr, fq, lds, wid, lane); S.done(cur); }
#undef PG8_SA
#undef PG8_SB
#undef PG8_STAGE
#undef PG8_LDA
#undef PG8_LDB
#undef PG8_MMA
#undef PG8_MMA_NP
#undef PG8_MMA2
#undef PG8_WAIT_V
#undef PG8_WAIT_L
#undef PG8_BAR
#undef PG8_SCHED
}
}
namespace att {
#define ATT_LAS __attribute__((address_space(3)))
typedef unsigned short bf16_t;
using bf16x8 = __attribute__((ext_vector_type(8))) short;
using s16x4  = __attribute__((ext_vector_type(4))) short;
using f32x16 = __attribute__((ext_vector_type(16))) float;
using f32x4v = __attribute__((ext_vector_type(4))) float;
using f32x2v = __attribute__((ext_vector_type(2))) float;
using u32x4  = __attribute__((ext_vector_type(4))) unsigned;
constexpr int KVBLK = 64, LDP = 9216, SEQL = 4096;
constexpr int PC_U = 0, PC_V = 1024, PC_Q = 2048, PC_K = 3072, PC_VA = 4096;
constexpr float SCALE = 0.125f;
constexpr float THR = 8.f;
constexpr int SHM_V = KVBLK * 128 * 2, SHM_K = KVBLK * 128 * 2, SHM_ATTN = 6 * SHM_V + 3 * SHM_K + 8 * 64 * 4 + 64;
static_assert(SHM_V == SHM_K, "one slot offset serves both rings");
#define KSWZ(row, colB) ((row) * 256 + ((colB) ^ (((row) & 7) << 4)))
#define SBAR() __builtin_amdgcn_sched_barrier(0)
__device__ __forceinline__ int crow(int r, int hi) { return (r & 3) + 8 * (r >> 2) + 4 * hi; }
__device__ __forceinline__ unsigned cvtpk(float lo, float hi) { unsigned r; asm volatile("v_cvt_pk_bf16_f32 %0, %1, %2" : "=v"(r) : "v"(lo), "v"(hi)); return r; }
__device__ __forceinline__ bf16x8 ld8(const bf16_t* p) { return *reinterpret_cast<const bf16x8*>(p); }
__device__ __forceinline__ float bf2f(short h) { return __uint_as_float(((unsigned)(unsigned short)h) << 16); }

__device__ __forceinline__ void partialSM(f32x16& p0, f32x16& p1, float& m_reg, float& mn, float& alpha) {
  constexpr float C = SCALE * 1.4426950408889634f;
  float pmax = p0[0];
#pragma unroll
  for (int r = 1; r < 16; ++r) pmax = fmaxf(pmax, p0[r]);
#pragma unroll
  for (int r = 0; r < 16; ++r) pmax = fmaxf(pmax, p1[r]);
  { auto rr = __builtin_amdgcn_permlane32_swap(__float_as_uint(pmax), __float_as_uint(pmax), false, false);
    pmax = fmaxf(__uint_as_float(rr[0]), __uint_as_float(rr[1])); }
  if (__builtin_expect(__all(pmax - m_reg <= THR / SCALE), 1)) { mn = m_reg; alpha = 1.f; }
  else { mn = fmaxf(m_reg, pmax); alpha = __builtin_amdgcn_exp2f((m_reg - mn) * C); m_reg = mn; }
  float mnC = -mn * C;
#ifdef PROBE_XEXP
  { float d0_, d1_, d2_, d3_;
#pragma unroll
    for (int r = 0; r < PROBE_XEXP; ++r) asm volatile(PROBE_XOP " %0, %4\n\t" PROBE_XOP " %1, %4\n\t" PROBE_XOP " %2, %4\n\t" PROBE_XOP " %3, %4" : "=&v"(d0_), "=&v"(d1_), "=&v"(d2_), "=&v"(d3_) : "v"(mnC)); }
#endif
#pragma unroll
  for (int r = 0; r < 16; ++r) p0[r] = fmaf(p0[r], C, mnC);
#pragma unroll
  for (int r = 0; r < 16; ++r) p1[r] = fmaf(p1[r], C, mnC);
#pragma unroll
  for (int r = 0; r < 16; ++r) p0[r] = __builtin_amdgcn_exp2f(p0[r]);
}
constexpr float THRL = 11.5f;
__device__ __forceinline__ void partialSM2(f32x16& p0, f32x16& p1, float& mref, f32x16& negm, float& alpha, bool first) {
  float pmax = p0[0];
#pragma unroll
  for (int r = 1; r < 16; ++r) pmax = fmaxf(pmax, p0[r]);
#pragma unroll
  for (int r = 0; r < 16; ++r) pmax = fmaxf(pmax, p1[r]);
  { auto rr = __builtin_amdgcn_permlane32_swap(__float_as_uint(pmax), __float_as_uint(pmax), false, false);
    pmax = fmaxf(__uint_as_float(rr[0]), __uint_as_float(rr[1])); }
  if (__builtin_expect(!first && __all(pmax <= THRL), 1)) { alpha = 1.f; }
  else { const float dl = first ? pmax : fmaxf(pmax, 0.f); mref += dl; alpha = first ? 0.f : __builtin_amdgcn_exp2f(-dl);
#pragma unroll
    for (int r = 0; r < 16; ++r) { p0[r] -= dl; p1[r] -= dl; }
#pragma unroll
    for (int r = 0; r < 16; ++r) negm[r] = -mref;
    asm volatile("" : "+v"(negm)); }
#pragma unroll
  for (int r = 0; r < 16; ++r) p0[r] = __builtin_amdgcn_exp2f(p0[r]);
}
__device__ __forceinline__ void finishSM(f32x16& p0, f32x16& p1, float alpha, float& l_reg, bf16x8& pa0, bf16x8& pa1, bf16x8& pa2, bf16x8& pa3, float* ps_out = nullptr) {
#pragma unroll
  for (int r = 0; r < 16; ++r) p1[r] = __builtin_amdgcn_exp2f(p1[r]);
  float ps = 0;
#pragma unroll
  for (int r = 0; r < 16; ++r) ps += p0[r];
#pragma unroll
  for (int r = 0; r < 16; ++r) ps += p1[r];
  { auto rr = __builtin_amdgcn_permlane32_swap(__float_as_uint(ps), __float_as_uint(ps), false, false);
    ps = __uint_as_float(rr[0]) + __uint_as_float(rr[1]); }
  l_reg = l_reg * alpha + ps; if (ps_out) *ps_out = ps;
#define PK4(P, BASE, OUT) do { unsigned a0 = cvtpk(P[BASE + 0], P[BASE + 1]), a1 = cvtpk(P[BASE + 2], P[BASE + 3]);   \
    unsigned b0 = cvtpk(P[BASE + 4], P[BASE + 5]), b1 = cvtpk(P[BASE + 6], P[BASE + 7]);                              \
    auto r0 = __builtin_amdgcn_permlane32_swap(a0, b0, false, false); auto r1 = __builtin_amdgcn_permlane32_swap(a1, b1, false, false); \
    u32x4 w = {r0[0], r1[0], r0[1], r1[1]}; OUT = *reinterpret_cast<bf16x8*>(&w); } while (0)
  PK4(p0, 0, pa0); PK4(p0, 8, pa1); PK4(p1, 0, pa2); PK4(p1, 8, pa3);
#undef PK4
}
__device__ __forceinline__ void finishSM_np(f32x16& p0, f32x16& p1, float alpha, float& l_reg, bf16x8& pa0, bf16x8& pa1, bf16x8& pa2, bf16x8& pa3, float* ps_out = nullptr, bool exp_p1 = true) {
  if (exp_p1) {
#pragma unroll
  for (int r = 0; r < 16; ++r) p1[r] = __builtin_amdgcn_exp2f(p1[r]); }
  float ps = 0;
#pragma unroll
  for (int r = 0; r < 16; ++r) ps += p0[r];
#pragma unroll
  for (int r = 0; r < 16; ++r) ps += p1[r];
  { auto rr = __builtin_amdgcn_permlane32_swap(__float_as_uint(ps), __float_as_uint(ps), false, false);
    ps = __uint_as_float(rr[0]) + __uint_as_float(rr[1]); }
  l_reg = l_reg * alpha + ps; if (ps_out) *ps_out = ps;
#define PK8(P, BASE, OUT) do { u32x4 w = {cvtpk(P[BASE + 0], P[BASE + 1]), cvtpk(P[BASE + 2], P[BASE + 3]), cvtpk(P[BASE + 4], P[BASE + 5]), cvtpk(P[BASE + 6], P[BASE + 7])}; OUT = *reinterpret_cast<bf16x8*>(&w); } while (0)
  PK8(p0, 0, pa0); PK8(p0, 8, pa1); PK8(p1, 0, pa2); PK8(p1, 8, pa3);
#undef PK8
}
__device__ __forceinline__ void qkt(f32x16& p0, f32x16& p1, const ATT_LAS char* Ks, const bf16x8* qr, int r32, int hi, int colb0) {
  p0 = f32x16{}; p1 = f32x16{};
#pragma unroll
  for (int d0 = 0; d0 < 4; ++d0) { const int cb = colb0 + (d0 * 16 + hi * 8) * 2;
    const bf16x8 b0 = *reinterpret_cast<const ATT_LAS bf16x8*>(Ks + KSWZ(r32, cb));
    const bf16x8 b1 = *reinterpret_cast<const ATT_LAS bf16x8*>(Ks + KSWZ(32 + r32, cb));
    p0 = __builtin_amdgcn_mfma_f32_32x32x16_bf16(b0, qr[d0], p0, 0, 0, 0);
    p1 = __builtin_amdgcn_mfma_f32_32x32x16_bf16(b1, qr[d0], p1, 0, 0, 0); }
}
__device__ __forceinline__ void qkt2(f32x16& p0, f32x16& p1, const ATT_LAS char* Ks, const bf16x8* qr, int r32, int hi, int colb0, const f32x16& negm) {
#pragma unroll
  for (int d0 = 0; d0 < 4; ++d0) { const int cb = colb0 + (d0 * 16 + hi * 8) * 2;
    const bf16x8 b0 = *reinterpret_cast<const ATT_LAS bf16x8*>(Ks + KSWZ(r32, cb));
    const bf16x8 b1 = *reinterpret_cast<const ATT_LAS bf16x8*>(Ks + KSWZ(32 + r32, cb));
    p0 = __builtin_amdgcn_mfma_f32_32x32x16_bf16(b0, qr[d0], d0 == 0 ? negm : p0, 0, 0, 0);
    p1 = __builtin_amdgcn_mfma_f32_32x32x16_bf16(b1, qr[d0], d0 == 0 ? negm : p1, 0, 0, 0); }
}
__device__ __forceinline__ int v_st(int k, int c) { const int kk = (k & ~0xC) | ((k & 4) << 1) | ((k & 8) >> 1); return ((kk >> 3) * 4 + (c >> 5)) * 512 + ((kk & 7) * 32 + (c & 31)) * 2; }
__device__ __forceinline__ int v_stp(int k, int c) { return ((k >> 3) * 4 + (c >> 5)) * 512 + ((k & 7) * 32 + (c & 31)) * 2; }
__device__ __forceinline__ int v_rd_base(int lane) { return ((lane & 3) << 3) | (((lane >> 2) & 3) << 6) | (((lane >> 4) & 1) << 5) | (((lane >> 5) & 1) << 8); }
constexpr int v_rd_off(int d0, int ks, int half) { return d0 * 512 + ks * 4096 + half * 2048; }
template <int OFF> __device__ __forceinline__ s16x4 tr_read(int vb) {
  s16x4 r; asm volatile("ds_read_b64_tr_b16 %0, %1 offset:%2" : "=&v"(r) : "v"(vb), "i"(OFF) : "memory"); return r;
}
template <int D0> __device__ __forceinline__ void pv_one(f32x16& od, int vb, bf16x8 pa0, bf16x8 pa1, bf16x8 pa2, bf16x8 pa3) {
  const s16x4 l0 = tr_read<v_rd_off(D0, 0, 0)>(vb), h0 = tr_read<v_rd_off(D0, 0, 1)>(vb), l1 = tr_read<v_rd_off(D0, 1, 0)>(vb), h1 = tr_read<v_rd_off(D0, 1, 1)>(vb);
  const s16x4 l2 = tr_read<v_rd_off(D0, 2, 0)>(vb), h2 = tr_read<v_rd_off(D0, 2, 1)>(vb), l3 = tr_read<v_rd_off(D0, 3, 0)>(vb), h3 = tr_read<v_rd_off(D0, 3, 1)>(vb);
  asm volatile("s_waitcnt lgkmcnt(0)" ::: "memory"); SBAR();
#define PK(L, H) (bf16x8){L[0], L[1], L[2], L[3], H[0], H[1], H[2], H[3]}
  od = __builtin_amdgcn_mfma_f32_32x32x16_bf16(pa0, PK(l0, h0), od, 0, 0, 0);
  od = __builtin_amdgcn_mfma_f32_32x32x16_bf16(pa1, PK(l1, h1), od, 0, 0, 0);
  od = __builtin_amdgcn_mfma_f32_32x32x16_bf16(pa2, PK(l2, h2), od, 0, 0, 0);
  od = __builtin_amdgcn_mfma_f32_32x32x16_bf16(pa3, PK(l3, h3), od, 0, 0, 0);
#undef PK
}
template <int D0, int SOFF> __device__ __forceinline__ void pv_one_s(f32x16& od, int vb, bf16x8 pa0, bf16x8 pa1, bf16x8 pa2, bf16x8 pa3) {
  const s16x4 l0 = tr_read<v_rd_off(D0, 0, 0) + SOFF>(vb), h0 = tr_read<v_rd_off(D0, 0, 1) + SOFF>(vb), l1 = tr_read<v_rd_off(D0, 1, 0) + SOFF>(vb), h1 = tr_read<v_rd_off(D0, 1, 1) + SOFF>(vb);
  const s16x4 l2 = tr_read<v_rd_off(D0, 2, 0) + SOFF>(vb), h2 = tr_read<v_rd_off(D0, 2, 1) + SOFF>(vb), l3 = tr_read<v_rd_off(D0, 3, 0) + SOFF>(vb), h3 = tr_read<v_rd_off(D0, 3, 1) + SOFF>(vb);
  asm volatile("s_waitcnt lgkmcnt(0)" ::: "memory"); SBAR();
#define PK(L, H) (bf16x8){L[0], L[1], L[2], L[3], H[0], H[1], H[2], H[3]}
  od = __builtin_amdgcn_mfma_f32_32x32x16_bf16(pa0, PK(l0, h0), od, 0, 0, 0);
  od = __builtin_amdgcn_mfma_f32_32x32x16_bf16(pa1, PK(l1, h1), od, 0, 0, 0);
  od = __builtin_amdgcn_mfma_f32_32x32x16_bf16(pa2, PK(l2, h2), od, 0, 0, 0);
  od = __builtin_amdgcn_mfma_f32_32x32x16_bf16(pa3, PK(l3, h3), od, 0, 0, 0);
#undef PK
}
template <int SOFF> __device__ __forceinline__ void pv_d0s(f32x16* o, int vb, bf16x8 pa0, bf16x8 pa1, bf16x8 pa2, bf16x8 pa3) {
  pv_one_s<0, SOFF>(o[0], vb, pa0, pa1, pa2, pa3); pv_one_s<1, SOFF>(o[1], vb, pa0, pa1, pa2, pa3); pv_one_s<2, SOFF>(o[2], vb, pa0, pa1, pa2, pa3); pv_one_s<3, SOFF>(o[3], vb, pa0, pa1, pa2, pa3);
}
__device__ __forceinline__ void pv_d0(f32x16* o, int vb, bf16x8 pa0, bf16x8 pa1, bf16x8 pa2, bf16x8 pa3) {
  pv_one<0>(o[0], vb, pa0, pa1, pa2, pa3); pv_one<1>(o[1], vb, pa0, pa1, pa2, pa3); pv_one<2>(o[2], vb, pa0, pa1, pa2, pa3); pv_one<3>(o[3], vb, pa0, pa1, pa2, pa3);
}
template <int D0> __device__ __forceinline__ void v_reads(s16x4 (&f)[8], int vb) {
  f[0] = tr_read<v_rd_off(D0, 0, 0)>(vb); f[1] = tr_read<v_rd_off(D0, 0, 1)>(vb); f[2] = tr_read<v_rd_off(D0, 1, 0)>(vb); f[3] = tr_read<v_rd_off(D0, 1, 1)>(vb);
  f[4] = tr_read<v_rd_off(D0, 2, 0)>(vb); f[5] = tr_read<v_rd_off(D0, 2, 1)>(vb); f[6] = tr_read<v_rd_off(D0, 3, 0)>(vb); f[7] = tr_read<v_rd_off(D0, 3, 1)>(vb);
}
__device__ __forceinline__ void pv_mma(f32x16& od, const s16x4 (&f)[8], bf16x8 pa0, bf16x8 pa1, bf16x8 pa2, bf16x8 pa3) {
#define PK(L, H) (bf16x8){L[0], L[1], L[2], L[3], H[0], H[1], H[2], H[3]}
  od = __builtin_amdgcn_mfma_f32_32x32x16_bf16(pa0, PK(f[0], f[1]), od, 0, 0, 0);
  od = __builtin_amdgcn_mfma_f32_32x32x16_bf16(pa1, PK(f[2], f[3]), od, 0, 0, 0);
  od = __builtin_amdgcn_mfma_f32_32x32x16_bf16(pa2, PK(f[4], f[5]), od, 0, 0, 0);
  od = __builtin_amdgcn_mfma_f32_32x32x16_bf16(pa3, PK(f[6], f[7]), od, 0, 0, 0);
#undef PK
}
template <int D0, int SOFF> __device__ __forceinline__ void v_reads_s(s16x4 (&f)[8], int vb) {
  f[0] = tr_read<v_rd_off(D0, 0, 0) + SOFF>(vb); f[1] = tr_read<v_rd_off(D0, 0, 1) + SOFF>(vb); f[2] = tr_read<v_rd_off(D0, 1, 0) + SOFF>(vb); f[3] = tr_read<v_rd_off(D0, 1, 1) + SOFF>(vb);
  f[4] = tr_read<v_rd_off(D0, 2, 0) + SOFF>(vb); f[5] = tr_read<v_rd_off(D0, 2, 1) + SOFF>(vb); f[6] = tr_read<v_rd_off(D0, 3, 0) + SOFF>(vb); f[7] = tr_read<v_rd_off(D0, 3, 1) + SOFF>(vb);
}
template <int SOFF> __device__ __forceinline__ void pv_pipe_s(f32x16* o, int vb, bf16x8 pa0, bf16x8 pa1, bf16x8 pa2, bf16x8 pa3) {
  s16x4 fa[8], fb[8];
  SBAR(); v_reads_s<0, SOFF>(fa, vb);
  v_reads_s<1, SOFF>(fb, vb); asm volatile("s_waitcnt lgkmcnt(8)" ::: "memory"); SBAR(); pv_mma(o[0], fa, pa0, pa1, pa2, pa3); SBAR();
  v_reads_s<2, SOFF>(fa, vb); asm volatile("s_waitcnt lgkmcnt(8)" ::: "memory"); SBAR(); pv_mma(o[1], fb, pa0, pa1, pa2, pa3); SBAR();
  v_reads_s<3, SOFF>(fb, vb); asm volatile("s_waitcnt lgkmcnt(8)" ::: "memory"); SBAR(); pv_mma(o[2], fa, pa0, pa1, pa2, pa3); SBAR();
  asm volatile("s_waitcnt lgkmcnt(0)" ::: "memory"); SBAR(); pv_mma(o[3], fb, pa0, pa1, pa2, pa3); SBAR();
}
__device__ __forceinline__ void pv_pipe(f32x16* o, int vb, bf16x8 pa0, bf16x8 pa1, bf16x8 pa2, bf16x8 pa3) {
  s16x4 fa[8], fb[8];
  SBAR(); v_reads<0>(fa, vb);
  v_reads<1>(fb, vb); asm volatile("s_waitcnt lgkmcnt(8)" ::: "memory"); SBAR(); pv_mma(o[0], fa, pa0, pa1, pa2, pa3); SBAR();
  v_reads<2>(fa, vb); asm volatile("s_waitcnt lgkmcnt(8)" ::: "memory"); SBAR(); pv_mma(o[1], fb, pa0, pa1, pa2, pa3); SBAR();
  v_reads<3>(fb, vb); asm volatile("s_waitcnt lgkmcnt(8)" ::: "memory"); SBAR(); pv_mma(o[2], fa, pa0, pa1, pa2, pa3); SBAR();
  asm volatile("s_waitcnt lgkmcnt(0)" ::: "memory"); SBAR(); pv_mma(o[3], fb, pa0, pa1, pa2, pa3); SBAR();
}

#ifndef ATT_ILV
#define ATT_ILV 1
#endif
#ifndef ATT_PVPIPE
#define ATT_PVPIPE 0
#endif
#ifndef ATT_FORCE_REDO
#define ATT_FORCE_REDO 0
#endif
template <bool FAST> __device__ __forceinline__ bool attn_unit_t(const bf16_t* __restrict__ QKV, bf16_t* __restrict__ BRB, int b, int h, int qb, float lam, float oml, const float* __restrict__ subg, ATT_LAS char* lds) {
  int tid_ = threadIdx.x; asm volatile("" : "+v"(tid_));
  const int tid = tid_, wid = __builtin_amdgcn_readfirstlane(tid >> 6), lane = tid & 63, r32 = lane & 31, hi = lane >> 5;
  const int map = wid >> 2, wq = wid & 3, colb0 = map * 128;
  ATT_LAS char* V_lds = lds; ATT_LAS char* K_lds = lds + 3 * SHM_V;
  ATT_LAS float* ws = (ATT_LAS float*)(lds + 3 * SHM_V + 3 * SHM_K) + wid * 64; ATT_LAS float* li_l = ws; ATT_LAS float* al_l = ws + 32;
  ATT_LAS unsigned* redo_w = (ATT_LAS unsigned*)(lds + 3 * SHM_V + 3 * SHM_K + 8 * 64 * 4);
  if (FAST && tid == 0) *redo_w = 0u;
  bool bad = false;
  float m_reg = 0.f, l_reg = 0; f32x16 o[4] = {}; bf16x8 qr[4]; f32x16 negm = {};
  const size_t tok0 = (size_t)b * SEQL + (size_t)qb * 128;
  constexpr int LDH = 128;
  const size_t hoff = (size_t)(b * 8 + h) * SEQL * LDH;
  const bf16_t* Kh = QKV + (size_t)32 * SEQL * LDH + hoff; const bf16_t* Vh = QKV + (size_t)64 * SEQL * LDH + hoff;
  const bf16_t* Qw = QKV + hoff + (size_t)(qb * 128 + wq * 32 + r32) * LDH + map * 64 + hi * 8;
#pragma unroll
  for (int d0 = 0; d0 < 4; ++d0) qr[d0] = ld8(Qw + d0 * 16);
  asm volatile("" :: "v"(qr[0]), "v"(qr[1]), "v"(qr[2]), "v"(qr[3]));
  const int sr = tid >> 4, sc = (tid & 15) * 8, vst0 = v_stp(sr, sc), vst1 = v_stp(32 + sr, sc);
  const int vb0 = (int)(uintptr_t)V_lds + v_rd_base(lane);
  struct { bf16x8 vs0, vs1, ks0, ks1; } sr_[1];
  const unsigned loff = (unsigned)(sr * LDH + sc) * 2u;
  const __amdgpu_buffer_rsrc_t rsK = __builtin_amdgcn_make_buffer_rsrc((void*)Kh, 0, SEQL * LDH * 2, 0x00020000);
  const __amdgpu_buffer_rsrc_t rsV = __builtin_amdgcn_make_buffer_rsrc((void*)Vh, 0, SEQL * LDH * 2, 0x00020000);
#define SLOAD(i, k0) do { const int so_ = (k0) * (LDH * 2); \
    sr_[i].vs0 = __builtin_bit_cast(bf16x8, __builtin_amdgcn_raw_buffer_load_b128(rsV, (int)loff, so_, 0)); sr_[i].vs1 = __builtin_bit_cast(bf16x8, __builtin_amdgcn_raw_buffer_load_b128(rsV, (int)loff, so_ + 32 * LDH * 2, 0)); \
    sr_[i].ks0 = __builtin_bit_cast(bf16x8, __builtin_amdgcn_raw_buffer_load_b128(rsK, (int)loff, so_, 0)); sr_[i].ks1 = __builtin_bit_cast(bf16x8, __builtin_amdgcn_raw_buffer_load_b128(rsK, (int)loff, so_ + 32 * LDH * 2, 0)); } while (0)
#define SWRITE(off, i) do { *(ATT_LAS bf16x8*)(V_lds + (off) + vst0) = sr_[i].vs0;          \
    *(ATT_LAS bf16x8*)(V_lds + (off) + vst1) = sr_[i].vs1; const int kc = sc * 2;               \
    *(ATT_LAS bf16x8*)(K_lds + (off) + KSWZ(sr, kc)) = sr_[i].ks0;                       \
    *(ATT_LAS bf16x8*)(K_lds + (off) + KSWZ(32 + sr, kc)) = sr_[i].ks1; } while (0)
#define SWAIT() do { } while (0)
#define RESC(a) do { if (__any((a) < 1.f)) { if (hi == 0) al_l[r32] = (a); asm volatile("s_waitcnt lgkmcnt(0)" ::: "memory"); \
    _Pragma("unroll") for (int d = 0; d < 4; ++d) _Pragma("unroll") for (int r = 0; r < 16; ++r) o[d][r] *= al_l[crow(r, hi)]; } } while (0)
#define ROT3() do { const int t_ = sl_prev; sl_prev = sl_cur; sl_cur = sl_next; sl_next = t_; } while (0)
#define PSM(X0, X1, alX) do { if (FAST) { alX = 1.f; _Pragma("unroll") for (int r_ = 0; r_ < 16; ++r_) X0[r_] = __builtin_amdgcn_exp2f(X0[r_]); } else partialSM2(X0, X1, m_reg, negm, alX, false); } while (0)
#define FSM(Y0, Y1, alY) do { if (FAST) { float ps_; finishSM_np(Y0, Y1, 1.f, l_reg, pa0, pa1, pa2, pa3, &ps_); bad |= !(ps_ < 1.2379400392853803e27f); } else finishSM_np(Y0, Y1, alY, l_reg, pa0, pa1, pa2, pa3); } while (0)
  f32x16 pA0, pA1, pB0, pB1; float alA, alB; bf16x8 pa0, pa1, pa2, pa3; constexpr int NT = SEQL / KVBLK;
  SLOAD(0, 0); asm volatile("s_waitcnt vmcnt(0)" ::: "memory"); SWRITE(0, 0); SLOAD(0, KVBLK); __syncthreads();
  qkt2(pA0, pA1, K_lds, qr, r32, hi, colb0, negm); partialSM2(pA0, pA1, m_reg, negm, alA, true);
  SWRITE(SHM_V, 0); SLOAD(0, 2 * KVBLK); __syncthreads();
#define ATT_STEP(X0, X1, alX, Y0, Y1, alY, j_, SP, SC, SN) do { \
    SBAR(); qkt2(X0, X1, K_lds + (SC), qr, r32, hi, colb0, negm); \
    FSM(Y0, Y1, alY); SBAR(); \
    pv_d0s<(SP)>(o, vb0, pa0, pa1, pa2, pa3); PSM(X0, X1, alX); \
    SWRITE((SN), 0); if ((j_) + 2 < NT) SLOAD(0, ((j_) + 2) * KVBLK); \
    if (!FAST) RESC(alX); __syncthreads(); } while (0)
  constexpr int S0 = 0, S1 = SHM_V, S2 = 2 * SHM_V;
  static_assert((NT - 4) % 6 == 0, "step loop: tiles 1 .. NT-4 in groups of six, then NT-3, NT-2, and the tail tile NT-1");
  for (int j = 1; j + 3 < NT; j += 6) {
    ATT_STEP(pB0, pB1, alB, pA0, pA1, alA, j,     S0, S1, S2);
    ATT_STEP(pA0, pA1, alA, pB0, pB1, alB, j + 1, S1, S2, S0);
    ATT_STEP(pB0, pB1, alB, pA0, pA1, alA, j + 2, S2, S0, S1);
    ATT_STEP(pA0, pA1, alA, pB0, pB1, alB, j + 3, S0, S1, S2);
    ATT_STEP(pB0, pB1, alB, pA0, pA1, alA, j + 4, S1, S2, S0);
    ATT_STEP(pA0, pA1, alA, pB0, pB1, alB, j + 5, S2, S0, S1);
  }
  ATT_STEP(pB0, pB1, alB, pA0, pA1, alA, NT - 3, S0, S1, S2);
  ATT_STEP(pA0, pA1, alA, pB0, pB1, alB, NT - 2, S1, S2, S0);
#undef ATT_STEP
  SBAR(); qkt2(pB0, pB1, K_lds + S0, qr, r32, hi, colb0, negm);
  FSM(pA0, pA1, alA); SBAR();
  pv_d0s<S2>(o, vb0, pa0, pa1, pa2, pa3); PSM(pB0, pB1, alB);
  if (!FAST) RESC(alB);
  FSM(pB0, pB1, alB); SBAR();
  pv_d0s<S0>(o, vb0, pa0, pa1, pa2, pa3);
#undef ROT3
#undef PSM
#undef FSM
  if (FAST) { if (__any(bad) && lane == 0) *redo_w = 1u; }
  if (hi == 0) li_l[r32] = l_reg; asm volatile("s_waitcnt lgkmcnt(0)" ::: "memory");
  float rli[16];
#pragma unroll
  for (int r = 0; r < 16; ++r) rli[r] = __builtin_amdgcn_rcpf(li_l[crow(r, hi)]);
  __syncthreads();
  if (FAST) { if (ATT_FORCE_REDO || __builtin_amdgcn_readfirstlane(*redo_w) != 0u) return true; }
  int tid2 = threadIdx.x; asm volatile("" : "+v"(tid2));
  const int lane2 = tid2 & 63, r32b = lane2 & 31, hib = lane2 >> 5;
  ATT_LAS float* ex = (ATT_LAS float*)lds + wq * 4096 + lane2;
  if (map == 1) {
#pragma unroll
    for (int d0 = 0; d0 < 4; ++d0)
#pragma unroll
      for (int r = 0; r < 16; ++r) ex[(d0 * 16 + r) * 64] = o[d0][r] * rli[r] * lam;
  }
  __syncthreads();
  if (map == 0) {
    float ss[16];
#pragma unroll
    for (int r = 0; r < 16; ++r) ss[r] = 0.f;
#pragma unroll
    for (int d0 = 0; d0 < 4; ++d0)
#pragma unroll
      for (int r = 0; r < 16; ++r) { const float v = o[d0][r] * rli[r] - ex[(d0 * 16 + r) * 64]; o[d0][r] = v; ss[r] += v * v; }
#pragma unroll
    for (int r = 0; r < 16; ++r) {
      float s = ss[r];
#define SHX(v_, o_) __uint_as_float((unsigned)__builtin_amdgcn_ds_bpermute((lane2 ^ (o_)) << 2, (int)__float_as_uint(v_)))
      s += SHX(s, 1); s += SHX(s, 2); s += SHX(s, 4); s += SHX(s, 8); s += SHX(s, 16);
#undef SHX
      ss[r] = oml / sqrtf(s * (1.0f / 128.0f) + 1e-6f);
    }
    ATT_LAS bf16_t* stg = (ATT_LAS bf16_t*)(lds + wq * 16384);
#pragma unroll
    for (int d0 = 0; d0 < 4; ++d0) { const float g = subg[d0 * 32 + r32b];
#pragma unroll
      for (int r = 0; r < 16; ++r) { const unsigned w = cvtpk(o[d0][r] * ss[r] * g, 0.f); stg[crow(r, hib) * 128 + d0 * 32 + r32b] = (bf16_t)(w & 0xffffu); } }
    asm volatile("s_waitcnt lgkmcnt(0)" ::: "memory");
    bf16_t* Ow = BRB + (tok0 + wq * 32) * 2048 + h * 128;
#pragma unroll
    for (int i = 0; i < 8; ++i) { const int id = i * 64 + lane2, row = id >> 4, ch = id & 15; *(bf16x8*)(Ow + (size_t)row * 2048 + ch * 8) = *(const ATT_LAS bf16x8*)(stg + row * 128 + ch * 8); }
  }
  __syncthreads();
#undef SLOAD
#undef SWRITE
#undef SWAIT
#undef RESC
  return false;
}

template <bool FAST> __device__ __forceinline__ bool attn_unit_d(const bf16_t* __restrict__ QKV, bf16_t* __restrict__ BRB, int b, int h, int qb, float lam, float oml, const float* __restrict__ subg, ATT_LAS char* lds) {
  int tid_ = threadIdx.x; asm volatile("" : "+v"(tid_));
  const int tid = tid_, wid = __builtin_amdgcn_readfirstlane(tid >> 6), lane = tid & 63, r32 = lane & 31, hi = lane >> 5;
  const int map = wid >> 2, wq = wid & 3, colb0 = map * 128;
  ATT_LAS char* V_lds = lds; ATT_LAS char* K_lds = lds + 6 * SHM_V;
  ATT_LAS float* ws = (ATT_LAS float*)(lds + 6 * SHM_V + 3 * SHM_K) + wid * 64; ATT_LAS float* li_l = ws; ATT_LAS float* al_l = ws + 32;
  ATT_LAS unsigned* redo_w = (ATT_LAS unsigned*)(lds + 6 * SHM_V + 3 * SHM_K + 8 * 64 * 4);
  if (FAST && tid == 0) *redo_w = 0u;
  bool bad = false;
  float m_reg = 0.f, l_reg = 0; f32x16 o[4] = {}; bf16x8 qr[4]; f32x16 negm = {};
  const size_t tok0 = (size_t)b * SEQL + (size_t)qb * 128;
  constexpr int LDH = 128;
  const size_t hoff = (size_t)(b * 8 + h) * SEQL * LDH;
  const bf16_t* Kh = QKV + (size_t)32 * SEQL * LDH + hoff; const bf16_t* Vh = QKV + (size_t)64 * SEQL * LDH + hoff;
  const int vb0 = (int)(uintptr_t)V_lds + v_rd_base(lane), vb3 = vb0 + 3 * SHM_V;
  const unsigned kvo0 = (unsigned)((8 * wid + (lane >> 4)) * 256 + (((lane & 15) ^ (lane >> 4)) << 4));
  const unsigned kvo1 = (unsigned)((8 * wid + (lane >> 4)) * 256 + 1024 + (((lane & 15) ^ ((lane >> 4) + 4)) << 4));
  const unsigned vvo0 = (unsigned)((8 * wid + ((lane & 31) >> 2)) * 256 + (lane >> 5) * 64 + (lane & 3) * 16), vvo1 = vvo0 + 128u;
  const unsigned kd0 = (unsigned)__builtin_amdgcn_readfirstlane((int)((unsigned)(uintptr_t)K_lds + (unsigned)wid * 2048u)), vd0 = (unsigned)__builtin_amdgcn_readfirstlane((int)((unsigned)(uintptr_t)V_lds + (unsigned)wid * 2048u));
#define ADMA(voff, sbase, ldsdst) asm volatile("s_mov_b32 m0, %2\n\tglobal_load_lds_dwordx4 %0, %1" :: "v"(voff), "s"(sbase), "s"(ldsdst) : "memory", "m0")
#define DMA(t, KS, VS) do { const char* kt_ = (const char*)Kh + (size_t)(t) * (KVBLK * LDH * 2); const char* vt_ = (const char*)Vh + (size_t)(t) * (KVBLK * LDH * 2); \
    ADMA(kvo0, kt_, kd0 + (unsigned)((KS) * SHM_K)); ADMA(kvo1, kt_, kd0 + (unsigned)((KS) * SHM_K) + 1024u); ADMA(vvo0, vt_, vd0 + (unsigned)((VS) * SHM_V)); ADMA(vvo1, vt_, vd0 + (unsigned)((VS) * SHM_V) + 1024u); } while (0)
#define DWAIT4() asm volatile("s_waitcnt vmcnt(4)" ::: "memory")
#define DWAIT0() asm volatile("s_waitcnt vmcnt(0)" ::: "memory")
  DMA(0, 0, 0); DMA(1, 1, 1);
  const bf16_t* Qw = QKV + hoff + (size_t)(qb * 128 + wq * 32 + r32) * LDH + map * 64 + hi * 8;
#pragma unroll
  for (int d0 = 0; d0 < 4; ++d0) qr[d0] = ld8(Qw + d0 * 16);
  asm volatile("" :: "v"(qr[0]), "v"(qr[1]), "v"(qr[2]), "v"(qr[3]));
  int kof[4];
#pragma unroll
  for (int d0 = 0; d0 < 4; ++d0) kof[d0] = KSWZ(r32, colb0 + (d0 * 16 + hi * 8) * 2);
#define RESC(a) do { if (__any((a) < 1.f)) { if (hi == 0) al_l[r32] = (a); asm volatile("s_waitcnt lgkmcnt(0)" ::: "memory"); \
    _Pragma("unroll") for (int d = 0; d < 4; ++d) _Pragma("unroll") for (int r = 0; r < 16; ++r) o[d][r] *= al_l[crow(r, hi)]; } } while (0)
#define ROT3() do { const int t_ = sl_prev; sl_prev = sl_cur; sl_cur = sl_next; sl_next = t_; } while (0)
#define PSM(X0, X1, alX) do { if (FAST) { alX = 1.f; _Pragma("unroll") for (int r_ = 0; r_ < 16; ++r_) X0[r_] = __builtin_amdgcn_exp2f(X0[r_]); } else partialSM2(X0, X1, m_reg, negm, alX, false); } while (0)
#define FSM(Y0, Y1, alY) do { if (FAST) { float ps_; finishSM_np(Y0, Y1, 1.f, l_reg, pa0, pa1, pa2, pa3, &ps_); bad |= !(ps_ < 1.2379400392853803e27f); } else finishSM_np(Y0, Y1, alY, l_reg, pa0, pa1, pa2, pa3); } while (0)
  f32x16 pA0, pA1, pB0, pB1; float alA, alB; bf16x8 pa0, pa1, pa2, pa3; constexpr int NT = SEQL / KVBLK;
  DWAIT4(); __syncthreads();
  qkt2(pA0, pA1, K_lds, qr, r32, hi, colb0, negm); partialSM2(pA0, pA1, m_reg, negm, alA, true);
  if (FAST && ATT_ILV) {
#pragma unroll
    for (int r = 0; r < 16; ++r) pA1[r] = __builtin_amdgcn_exp2f(pA1[r]); }
  DMA(2, 2, 2); DWAIT4(); __syncthreads();
#define PVS(VP) do { if (FAST && ATT_PVPIPE) { if ((VP) < 3) pv_pipe_s<(VP) * SHM_V>(o, vb0, pa0, pa1, pa2, pa3); else pv_pipe_s<((VP) - 3) * SHM_V>(o, vb3, pa0, pa1, pa2, pa3); } \
    else { if ((VP) < 3) pv_d0s<(VP) * SHM_V>(o, vb0, pa0, pa1, pa2, pa3); else pv_d0s<((VP) - 3) * SHM_V>(o, vb3, pa0, pa1, pa2, pa3); } } while (0)
#define KRD(KC, d0_, o_) (*reinterpret_cast<const ATT_LAS bf16x8*>(K_lds + (KC) * SHM_K + kof[d0_] + (o_)))
#define MF32(A_, B_, C_) __builtin_amdgcn_mfma_f32_32x32x16_bf16(A_, B_, C_, 0, 0, 0)
#define G1F(ACC, KF, d0_, CIN, W, wa, wb, P, pb, Yv, ya) do { ACC = MF32(KF, qr[d0_], CIN); W[wa] = cvtpk(P[pb], P[pb + 1]); W[wb] = cvtpk(P[pb + 2], P[pb + 3]); ps_ += Yv[ya + 1]; SBAR(); } while (0)
#define G1(ACC, KF, d0_, CIN, W, wa, wb, P, pb, Yv, ya) do { ACC = MF32(KF, qr[d0_], CIN); W[wa] = cvtpk(P[pb], P[pb + 1]); W[wb] = cvtpk(P[pb + 2], P[pb + 3]); ps_ += Yv[ya]; ps_ += Yv[ya + 1]; SBAR(); } while (0)
#define PKF(F, i_) (bf16x8){F[2 * (i_)][0], F[2 * (i_)][1], F[2 * (i_)][2], F[2 * (i_)][3], F[2 * (i_) + 1][0], F[2 * (i_) + 1][1], F[2 * (i_) + 1][2], F[2 * (i_) + 1][3]}
#define G2(OD, PA_, F, i_, XE, xe, Yv, ya) do { OD = MF32(PA_, PKF(F, i_), OD); XE[xe] = __builtin_amdgcn_exp2f(XE[xe]); asm volatile("" : "+v"(XE[xe])); ps_ += Yv[ya]; asm volatile("" : "+v"(ps_)); XE[xe + 1] = __builtin_amdgcn_exp2f(XE[xe + 1]); SBAR(); } while (0)
#define PVBLK(d0_, F, XE, xb, yb) do { G2(o[d0_], pa0, F, 0, XE, xb, Y1_, yb); G2(o[d0_], pa1, F, 1, XE, xb + 2, Y1_, yb + 1); G2(o[d0_], pa2, F, 2, XE, xb + 4, Y1_, yb + 2); G2(o[d0_], pa3, F, 3, XE, xb + 6, Y1_, yb + 3); } while (0)
  bf16x8 ka_, kb_, kc_, kd_;
  if (FAST && ATT_ILV) { ka_ = KRD(1, 0, 0); kb_ = KRD(1, 0, 8192); kc_ = KRD(1, 1, 0); kd_ = KRD(1, 1, 8192); }
#define FSTEP(X0, X1, Y0, Y1, j_, KC, VP, KD, VD, KN) do { \
    if ((j_) + 2 < NT) DMA((j_) + 2, KD, VD); \
    SBAR(); \
    { f32x16& Y1_ = Y1; float ps_ = Y0[0]; u32x4 w0_, w1_, w2_, w3_;     \
      G1F(X0, ka_, 0, negm, w0_, 0, 1, Y0, 0, Y0, 0);  G1(X1, kb_, 0, negm, w0_, 2, 3, Y0, 4, Y0, 2); \
      ka_ = KRD(KC, 2, 0); kb_ = KRD(KC, 2, 8192); \
      G1(X0, kc_, 1, X0, w1_, 0, 1, Y0, 8, Y0, 4);    G1(X1, kd_, 1, X1, w1_, 2, 3, Y0, 12, Y0, 6); \
      kc_ = KRD(KC, 3, 0); kd_ = KRD(KC, 3, 8192); \
      G1(X0, ka_, 2, X0, w2_, 0, 1, Y1, 0, Y0, 8);    G1(X1, kb_, 2, X1, w2_, 2, 3, Y1, 4, Y0, 10); \
      G1(X0, kc_, 3, X0, w3_, 0, 1, Y1, 8, Y0, 12);   G1(X1, kd_, 3, X1, w3_, 2, 3, Y1, 12, Y0, 14); \
      pa0 = __builtin_bit_cast(bf16x8, w0_); pa1 = __builtin_bit_cast(bf16x8, w1_); pa2 = __builtin_bit_cast(bf16x8, w2_); pa3 = __builtin_bit_cast(bf16x8, w3_); \
      { constexpr int VO_ = ((VP) < 3 ? (VP) : (VP) - 3) * SHM_V; const int vbb_ = (VP) < 3 ? vb0 : vb3; s16x4 fa_[8], fb_[8]; \
        v_reads_s<0, VO_>(fa_, vbb_); \
        v_reads_s<1, VO_>(fb_, vbb_); \
        if ((j_) + 2 < NT) DWAIT4(); else DWAIT0(); \
        asm volatile("s_barrier" ::: "memory"); \
        asm volatile("s_waitcnt lgkmcnt(8)" ::: "memory"); SBAR(); PVBLK(0, fa_, X0, 0, 0); \
        v_reads_s<2, VO_>(fa_, vbb_); asm volatile("s_waitcnt lgkmcnt(8)" ::: "memory"); SBAR(); PVBLK(1, fb_, X0, 8, 4); \
        v_reads_s<3, VO_>(fb_, vbb_); asm volatile("s_waitcnt lgkmcnt(8)" ::: "memory"); SBAR(); PVBLK(2, fa_, X1, 0, 8); \
        if ((KN) >= 0) { ka_ = KRD((KN) < 0 ? 0 : (KN), 0, 0); kb_ = KRD((KN) < 0 ? 0 : (KN), 0, 8192); kc_ = KRD((KN) < 0 ? 0 : (KN), 1, 0); kd_ = KRD((KN) < 0 ? 0 : (KN), 1, 8192); \
                         asm volatile("s_waitcnt lgkmcnt(4)" ::: "memory"); } else asm volatile("s_waitcnt lgkmcnt(0)" ::: "memory"); \
        SBAR(); PVBLK(3, fb_, X1, 8, 12); } \
      asm volatile("" : "+v"(ps_)); l_reg += ps_; } } while (0)
#define ATT_STEP(X0, X1, alX, Y0, Y1, alY, j_, KC, VP, KD, VD) do { \
    if ((j_) + 2 < NT) DMA((j_) + 2, KD, VD); \
    SBAR(); qkt2(X0, X1, K_lds + (KC) * SHM_K, qr, r32, hi, colb0, negm); \
    FSM(Y0, Y1, alY); SBAR(); \
    PVS(VP); PSM(X0, X1, alX); \
    if (!FAST) RESC(alX); \
    if ((j_) + 2 < NT) DWAIT4(); else DWAIT0(); __syncthreads(); } while (0)
  static_assert((NT - 4) % 6 == 0, "step loop: tiles 1 .. NT-4 in groups of six, then NT-3, NT-2, and the tail tile NT-1");
#define STEP_(X0, X1, alX, Y0, Y1, alY, j_, KC, VP, KD, VD) do { if (FAST && ATT_ILV) FSTEP(X0, X1, Y0, Y1, j_, KC, VP, KD, VD, ((KC) + 1) % 3); else ATT_STEP(X0, X1, alX, Y0, Y1, alY, j_, KC, VP, KD, VD); } while (0)
  for (int j = 1; j + 3 < NT; j += 6) {
    STEP_(pB0, pB1, alB, pA0, pA1, alA, j,     1, 0, 0, 3);
    STEP_(pA0, pA1, alA, pB0, pB1, alB, j + 1, 2, 1, 1, 4);
    STEP_(pB0, pB1, alB, pA0, pA1, alA, j + 2, 0, 2, 2, 5);
    STEP_(pA0, pA1, alA, pB0, pB1, alB, j + 3, 1, 3, 0, 0);
    STEP_(pB0, pB1, alB, pA0, pA1, alA, j + 4, 2, 4, 1, 1);
    STEP_(pA0, pA1, alA, pB0, pB1, alB, j + 5, 0, 5, 2, 2);
  }
  STEP_(pB0, pB1, alB, pA0, pA1, alA, NT - 3, 1, 0, 0, 3);
  STEP_(pA0, pA1, alA, pB0, pB1, alB, NT - 2, 2, 1, 1, 4);
  if (FAST && ATT_ILV) {
    FSTEP(pB0, pB1, pA0, pA1, NT - 1, 0, 2, 0, 0, -1);
    { auto rr_ = __builtin_amdgcn_permlane32_swap(__float_as_uint(l_reg), __float_as_uint(l_reg), false, false); l_reg = __uint_as_float(rr_[0]) + __uint_as_float(rr_[1]); }
    bad |= !(l_reg < 1.2379400392853803e27f);
    { float ps_; finishSM_np(pB0, pB1, 1.f, l_reg, pa0, pa1, pa2, pa3, &ps_, false); bad |= !(ps_ < 1.2379400392853803e27f); }
    SBAR(); PVS(3);
  } else {
  SBAR(); qkt2(pB0, pB1, K_lds + 0 * SHM_K, qr, r32, hi, colb0, negm);
  FSM(pA0, pA1, alA); SBAR();
  PVS(2); PSM(pB0, pB1, alB);
  if (!FAST) RESC(alB);
  FSM(pB0, pB1, alB); SBAR();
  PVS(3);
  }
#undef ATT_STEP
#undef STEP_
#undef FSTEP
#undef KRD
#undef MF32
#undef G1
#undef G1F
#undef G2
#undef PKF
#undef PVBLK
#undef PVS
#undef ROT3
#undef PSM
#undef FSM
  if (FAST) { if (__any(bad) && lane == 0) *redo_w = 1u; }
  if (hi == 0) li_l[r32] = l_reg; asm volatile("s_waitcnt lgkmcnt(0)" ::: "memory");
  float rli[16];
#pragma unroll
  for (int r = 0; r < 16; ++r) rli[r] = __builtin_amdgcn_rcpf(li_l[crow(r, hi)]);
  __syncthreads();
  if (FAST) { if (ATT_FORCE_REDO || __builtin_amdgcn_readfirstlane(*redo_w) != 0u) return true; }
  int tid2 = threadIdx.x; asm volatile("" : "+v"(tid2));
  const int lane2 = tid2 & 63, r32b = lane2 & 31, hib = lane2 >> 5;
  ATT_LAS float* ex = (ATT_LAS float*)lds + wq * 4096 + lane2;
  if (map == 1) {
#pragma unroll
    for (int d0 = 0; d0 < 4; ++d0)
#pragma unroll
      for (int r = 0; r < 16; ++r) ex[(d0 * 16 + r) * 64] = o[d0][r] * rli[r] * lam;
  }
  __syncthreads();
  if (map == 0) {
    float ss[16];
#pragma unroll
    for (int r = 0; r < 16; ++r) ss[r] = 0.f;
#pragma unroll
    for (int d0 = 0; d0 < 4; ++d0)
#pragma unroll
      for (int r = 0; r < 16; ++r) { const float v = o[d0][r] * rli[r] - ex[(d0 * 16 + r) * 64]; o[d0][r] = v; ss[r] += v * v; }
#pragma unroll
    for (int r = 0; r < 16; ++r) {
      float s = ss[r];
#define SHX(v_, o_) __uint_as_float((unsigned)__builtin_amdgcn_ds_bpermute((lane2 ^ (o_)) << 2, (int)__float_as_uint(v_)))
      s += SHX(s, 1); s += SHX(s, 2); s += SHX(s, 4); s += SHX(s, 8); s += SHX(s, 16);
#undef SHX
      ss[r] = oml / sqrtf(s * (1.0f / 128.0f) + 1e-6f);
    }
    ATT_LAS bf16_t* stg = (ATT_LAS bf16_t*)(lds + wq * 16384);
#pragma unroll
    for (int d0 = 0; d0 < 4; ++d0) { const float g = subg[d0 * 32 + r32b];
#pragma unroll
      for (int r = 0; r < 16; ++r) { const unsigned w = cvtpk(o[d0][r] * ss[r] * g, 0.f); stg[crow(r, hib) * 128 + d0 * 32 + r32b] = (bf16_t)(w & 0xffffu); } }
    asm volatile("s_waitcnt lgkmcnt(0)" ::: "memory");
    bf16_t* Ow = BRB + (tok0 + wq * 32) * 2048 + h * 128;
#pragma unroll
    for (int i = 0; i < 8; ++i) { const int id = i * 64 + lane2, row = id >> 4, ch = id & 15; *(bf16x8*)(Ow + (size_t)row * 2048 + ch * 8) = *(const ATT_LAS bf16x8*)(stg + row * 128 + ch * 8); }
  }
  __syncthreads();
#undef ADMA
#undef DMA
#undef DWAIT4
#undef DWAIT0
#undef RESC
  return false;
}


constexpr int GM_ST = 32768, GM_U = 36864, GM_O = GM_U + 32768, GM_END = GM_O + 32768;
template <bool DYN> __device__ __forceinline__ void gmlp_units(const bf16_t* __restrict__ P, bf16_t* __restrict__ BRA, const f32x2v* __restrict__ vstat, const bf16_t* __restrict__ WSb, const float* __restrict__ bs,
                                           const float* __restrict__ lng, const float* __restrict__ lnb, int u0, int ustep, int nunits, ATT_LAS char* lds, unsigned* gq = nullptr, volatile ATT_LAS unsigned* gw = nullptr) {
  int tid_ = threadIdx.x; asm volatile("" : "+v"(tid_));
  const int tid = tid_, wid = __builtin_amdgcn_readfirstlane(tid >> 6), lane = tid & 63, r32 = lane & 31, hi = lane >> 5;
  const int pblk = wid & 3, dpair = wid >> 2;
  ATT_LAS f32x2v* st = (ATT_LAS f32x2v*)(lds + GM_ST);
  const int sr = tid >> 4, sc = (tid & 15) * 8;
  bf16x8 af[8], xv[4], xu[4]; f32x4v g0, g1, b0, b1, t[8]; float bsv[16];
#define GM_LOAD_X(u_) do { const int g_ = (u_) & 7, bn_ = (u_) >> 3; const size_t tok_ = (size_t)(bn_ >> 5) * SEQL + (size_t)(bn_ & 31) * 128; \
    _Pragma("unroll") for (int j = 0; j < 4; ++j) { const bf16_t* rp = P + (tok_ + sr + 32 * j) * LDP + g_ * 128 + sc; xv[j] = __builtin_nontemporal_load((const bf16x8*)(rp + PC_V)); xu[j] = __builtin_nontemporal_load((const bf16x8*)(rp + PC_U)); } \
    if (tid < 128) { const f32x4v* sp = (const f32x4v*)(vstat + (tok_ + tid) * 16); _Pragma("unroll") for (int i = 0; i < 8; ++i) t[i] = __builtin_nontemporal_load(&sp[i]); } } while (0)
#define GM_LOAD_W(u_) do { const int g_ = (u_) & 7; const bf16_t* wrow = WSb + ((size_t)g_ * 128 + pblk * 32 + r32) * 128 + hi * 8; \
    _Pragma("unroll") for (int ks = 0; ks < 8; ++ks) af[ks] = ld8(wrow + ks * 16); \
    g0 = *(const f32x4v*)(lng + g_ * 128 + sc); g1 = *(const f32x4v*)(lng + g_ * 128 + sc + 4); b0 = *(const f32x4v*)(lnb + g_ * 128 + sc); b1 = *(const f32x4v*)(lnb + g_ * 128 + sc + 4); \
    _Pragma("unroll") for (int r = 0; r < 16; ++r) bsv[r] = bs[g_ * 128 + pblk * 32 + crow(r, hi)]; } while (0)
  unsigned unq = (unsigned)nunits;
  if (DYN && tid == 0) unq = __hip_atomic_fetch_add(gq, 1u, __ATOMIC_RELAXED, __HIP_MEMORY_SCOPE_AGENT);
  if (u0 < nunits) { GM_LOAD_X(u0); GM_LOAD_W(u0); }
  for (int u = u0; u < nunits; ) {
    const int g = u & 7, bn = u >> 3; const size_t tok0 = (size_t)(bn >> 5) * SEQL + (size_t)(bn & 31) * 128; const int ch0 = g * 128;
    if (tid < 128) {
      float ms = 0.f;
#pragma unroll
      for (int i = 0; i < 8; ++i) ms += t[i][0] + t[i][2];
      const float mean = ms * (1.0f / 16.0f); float m2 = 0.f;
#pragma unroll
      for (int i = 0; i < 8; ++i) { const float d0 = t[i][0] - mean, d1 = t[i][2] - mean; m2 += t[i][1] + t[i][3] + 64.0f * (d0 * d0 + d1 * d1); }
      st[tid] = (f32x2v){mean, 1.0f / sqrtf(m2 * (1.0f / 1024.0f) + 1e-6f)};
    }
#pragma unroll
    for (int j = 0; j < 4; ++j) *(ATT_LAS bf16x8*)(lds + GM_U + (sr + 32 * j) * 256 + sc * 2) = xu[j];
    if (DYN && tid == 0) { gw[0] = unq; unq = __hip_atomic_fetch_add(gq, 1u, __ATOMIC_RELAXED, __HIP_MEMORY_SCOPE_AGENT); }
    __syncthreads();
    const int un = DYN ? __builtin_amdgcn_readfirstlane((int)gw[0]) : u + ustep;
#pragma unroll
    for (int j = 0; j < 4; ++j) { const int q = sr + 32 * j; const bf16x8 x = xv[j]; const f32x2v mr = st[q];
      u32x4 w;
      w.x = cvtpk((bf2f(x[0]) - mr.x) * mr.y * g0[0] + b0[0], (bf2f(x[1]) - mr.x) * mr.y * g0[1] + b0[1]);
      w.y = cvtpk((bf2f(x[2]) - mr.x) * mr.y * g0[2] + b0[2], (bf2f(x[3]) - mr.x) * mr.y * g0[3] + b0[3]);
      w.z = cvtpk((bf2f(x[4]) - mr.x) * mr.y * g1[0] + b1[0], (bf2f(x[5]) - mr.x) * mr.y * g1[1] + b1[1]);
      w.w = cvtpk((bf2f(x[6]) - mr.x) * mr.y * g1[2] + b1[2], (bf2f(x[7]) - mr.x) * mr.y * g1[3] + b1[3]);
      *(ATT_LAS u32x4*)(lds + (q >> 6) * SHM_V + v_st(q & 63, sc)) = w; }
    const bool more = un < nunits;
    if (more) GM_LOAD_X(un);
    __syncthreads();
    const int vb = (int)(uintptr_t)lds + v_rd_base(lane) + dpair * 1024;
    f32x16 o0 = {}, o1 = {};
    pv_one<0>(o0, vb, af[0], af[1], af[2], af[3]); pv_one<0>(o0, vb + SHM_V, af[4], af[5], af[6], af[7]);
    pv_one<1>(o1, vb, af[0], af[1], af[2], af[3]); pv_one<1>(o1, vb + SHM_V, af[4], af[5], af[6], af[7]);
    { const ATT_LAS bf16_t* Ul = (const ATT_LAS bf16_t*)(lds + GM_U) + (pblk * 32) * 128 + dpair * 64 + r32;
      ATT_LAS bf16_t* Ol = (ATT_LAS bf16_t*)(lds + GM_O) + (pblk * 32) * 128 + dpair * 64 + r32;
#pragma unroll
      for (int r = 0; r < 16; ++r) { const int p = crow(r, hi);
        const float u0_ = bf2f((short)Ul[p * 128]), u1_ = bf2f((short)Ul[p * 128 + 32]);
        const unsigned w0 = cvtpk(u0_ * (o0[r] + bsv[r]), 0.f), w1 = cvtpk(u1_ * (o1[r] + bsv[r]), 0.f);
        Ol[p * 128] = (bf16_t)(w0 & 0xffffu); Ol[p * 128 + 32] = (bf16_t)(w1 & 0xffffu); } }
    if (more) GM_LOAD_W(un);
    __syncthreads();
#pragma unroll
    for (int j = 0; j < 4; ++j) { const int q = sr + 32 * j; *(bf16x8*)(BRA + (tok0 + q) * 2048 + ch0 + sc) = *(const ATT_LAS bf16x8*)(lds + GM_O + q * 256 + sc * 2); }
    u = un;
  }
#undef GM_LOAD_X
#undef GM_LOAD_W
}
#undef KSWZ
#undef SBAR
}
#define GAS __attribute__((address_space(1)))
#define LAS __attribute__((address_space(3)))
typedef unsigned short bf16;
typedef unsigned v4u __attribute__((ext_vector_type(4)));
typedef float f32x4 __attribute__((ext_vector_type(4)));
typedef short bf16x8 __attribute__((ext_vector_type(8)));
typedef GAS unsigned gu32;
typedef GAS unsigned long long gu64;
#define RLX_AGENT __ATOMIC_RELAXED, __HIP_MEMORY_SCOPE_AGENT
#define LDS_WAIT() asm volatile("s_waitcnt lgkmcnt(0)" ::: "memory")
#define VM_WAIT() asm volatile("s_waitcnt vmcnt(0)" ::: "memory")
__device__ __forceinline__ unsigned long long rt() { return __builtin_amdgcn_s_memrealtime(); }
__device__ __forceinline__ unsigned f2bf(float f) { unsigned u = __builtin_bit_cast(unsigned, f); return (u + 0x7fffu + ((u >> 16) & 1u)) >> 16; }
__device__ __forceinline__ unsigned pk2(float lo, float hi) { return f2bf(lo) | (f2bf(hi) << 16); }

#define XB_TMO      128
#define XB_XCNT(j)  (256  + 64 * (j))
#define XB_XSUB(j)  (1280 + 64 * (j))
#define XB_XGEN(j)  (2304 + 64 * (j))
#define XB_TOP      3328
#define XB_TOPGEN   3392
#define XCD_BAR_WORDS 3456
#define XB_LSUB(j)  (3456 + 64 * (j))
#define XB_LGEN(j)  (4096 + 64 * (j))
#define XB_GRPX(j)  (4608 + 64 * (j))
#define XB_QSUB(q)  (8192 + 64 * (q))
#define XB_QGEN(q)  (12288 + 64 * (q))
#define XB_NONLOC   5184
#define XB_SPIN_CAP (1u << 18)

__device__ __forceinline__ unsigned xb_ld(unsigned* p)              { return __hip_atomic_load(p, __ATOMIC_RELAXED, __HIP_MEMORY_SCOPE_AGENT); }
__device__ __forceinline__ unsigned xb_add(unsigned* p, unsigned v) { return __hip_atomic_fetch_add(p, v, __ATOMIC_RELAXED, __HIP_MEMORY_SCOPE_AGENT); }
__device__ __forceinline__ unsigned xb_xcc_id() { return (unsigned)__builtin_amdgcn_s_getreg((3 << 11) | 20) & 0xFu; }
#define XB_SPIN(cond, bar) do { unsigned _sp = 0; while (cond) { __builtin_amdgcn_s_sleep(1); \
    if ((++_sp & 255u) == 0u) { if (xb_ld(&(bar)[XB_TMO])) break; if (_sp > XB_SPIN_CAP) { atomicAdd(&(bar)[XB_TMO], 1u); break; } } } } while (0)

struct XcdBarrier {
    unsigned* bar; unsigned x;
    volatile LAS unsigned* st;
};

__device__ __forceinline__ XcdBarrier xcd_barrier_post(unsigned* bar, volatile LAS unsigned* st) {
    XcdBarrier b; b.bar = bar; b.x = xb_xcc_id(); b.st = st;
    if (threadIdx.x == 0) { (void)xb_add(&bar[XB_XCNT(b.x)], 1u);
        const unsigned g_ = blockIdx.x & 7u, me_ = b.x + 1u; const unsigned old_ = atomicCAS(&bar[XB_GRPX(g_)], 0u, me_);
        if ((old_ != 0u && old_ != me_) || gridDim.x != 256u) (void)xb_add(&bar[XB_NONLOC], 1u); }
    return b;
}
__device__ __forceinline__ void xcd_barrier_complete(unsigned* bar, unsigned x, unsigned& nloc, unsigned& nx) {
    const unsigned G = gridDim.x * gridDim.y * gridDim.z;
    unsigned sum, cnt, mine, sp = 0u;
    for (;;) {
        sum = 0u; cnt = 0u; mine = 0u;
#pragma unroll
        for (unsigned j = 0; j < 16; ++j) { const unsigned c = xb_ld(&bar[XB_XCNT(j)]); sum += c; cnt += (c > 0u) ? 1u : 0u; mine = (j == x) ? c : mine; }
        if (sum == G) break;
        __builtin_amdgcn_s_sleep(1);
        if ((++sp & 255u) == 0u) { if (xb_ld(&bar[XB_TMO])) break; if (sp > XB_SPIN_CAP) { atomicAdd(&bar[XB_TMO], 1u); break; } }
    }
    nloc = mine > 0u ? mine : 1u; nx = cnt > 0u ? cnt : 1u;
}

__device__ __forceinline__ void xcd_barrier(const XcdBarrier& b) {
    asm volatile("s_waitcnt vmcnt(0)" ::: "memory");
    __syncthreads();
    int xb_tid_ = threadIdx.x; asm volatile("" : "+v"(xb_tid_));
    if (xb_tid_ == 0) {
        unsigned* bar = b.bar;
        __builtin_amdgcn_s_waitcnt(0);
        unsigned nloc = b.st[0], nx = b.st[1];
        if (nloc == 0u) { xcd_barrier_complete(bar, b.x, nloc, nx); b.st[0] = nloc; b.st[1] = nx; }
        const unsigned old = xb_add(&bar[XB_XSUB(b.x)], 1u);
        const unsigned gen = old / nloc;
        if (old + 1u == (gen + 1u) * nloc) {
            __builtin_amdgcn_fence(__ATOMIC_RELEASE, "agent");
            asm volatile("s_waitcnt vmcnt(0)" ::: "memory");
            const unsigned og = xb_add(&bar[XB_TOP], 1u);
            const unsigned tg = og / nx;
            if (og + 1u == (tg + 1u) * nx) xb_add(&bar[XB_TOPGEN], 1u);
            else XB_SPIN(xb_ld(&bar[XB_TOPGEN]) == tg, bar);
            __builtin_amdgcn_fence(__ATOMIC_ACQUIRE, "agent");
            xb_add(&bar[XB_XGEN(b.x)], 1u);
            asm volatile("s_waitcnt vmcnt(0)" ::: "memory");
        } else {
            XB_SPIN(xb_ld(&bar[XB_XGEN(b.x)]) == gen, bar);
            __builtin_amdgcn_fence(__ATOMIC_ACQUIRE, "agent");
            asm volatile("s_waitcnt vmcnt(0)" ::: "memory");
        }
    }
    __syncthreads();
}

__device__ __forceinline__ void quad_barrier(const XcdBarrier& b) {
    asm volatile("s_waitcnt vmcnt(0)" ::: "memory");
    __syncthreads();
    int xb_tid_ = threadIdx.x; asm volatile("" : "+v"(xb_tid_));
    if (xb_tid_ == 0) {
        unsigned* bar = b.bar;
        __builtin_amdgcn_s_waitcnt(0);
        const unsigned q = (blockIdx.x & 7u) * 8u + ((blockIdx.x >> 3) & 7u); constexpr unsigned nloc = 4u;
        const unsigned old = xb_add(&bar[XB_QSUB(q)], 1u);
        const unsigned gen = old / nloc;
        if (old + 1u == (gen + 1u) * nloc) xb_add(&bar[XB_QGEN(q)], 1u);
        else XB_SPIN(xb_ld(&bar[XB_QGEN(q)]) == gen, bar);
        __builtin_amdgcn_fence(__ATOMIC_ACQUIRE, "agent");
        asm volatile("s_waitcnt vmcnt(0)" ::: "memory");
    }
    __syncthreads();
}

constexpr int NWAVES = 8;
constexpr int NCU_NOM = 256;
constexpr int DM = 2048, NB = 4, SEQ = 4096, DEPTH = 4, MTOK = NB * SEQ;
constexpr int DIN = 9216, FFH = 5632, NF13 = 2 * FFH, MODW = 6 * DM;
constexpr int PC_V = 1024, PC_G0 = 5120, PC_G1 = 7168;
constexpr float EPS = 1e-6f;
constexpr size_t MiB = 1u << 20;
constexpr size_t WS_CTL = 0, CTL_ZERO_BYTES = 1 * MiB;
constexpr size_t WS_MOD = 1 * MiB;
constexpr size_t WS_ROPE = 2 * MiB;
constexpr size_t WS_LAM = 3 * MiB;
constexpr size_t WS_WSB = 4 * MiB;
constexpr size_t WS_VSTAT = 5 * MiB;
constexpr size_t WS_WIN = 8 * MiB;
constexpr size_t WS_WUG = 152 * MiB;
constexpr size_t WS_WUA = 168 * MiB;
constexpr size_t WS_WO = 184 * MiB;
constexpr size_t WS_W13 = 216 * MiB;
constexpr size_t WS_W2 = 392 * MiB;
constexpr size_t WS_X = 480 * MiB;
constexpr size_t WS_H = 608 * MiB;
constexpr size_t WS_BRA = 672 * MiB;
constexpr size_t WS_BRB = 704 * MiB;
constexpr size_t WS_MG = 736 * MiB;
constexpr size_t WS_P = 800 * MiB;
constexpr size_t WS_QKV = 1088 * MiB;
constexpr size_t WS_D = 1184 * MiB;
constexpr size_t WS_T = 1312 * MiB;
constexpr size_t WS_END = 1488 * MiB;
constexpr int CW_TMO = 0, CW_CODE = 1, CW_BAR = 4096, CW_UV = 32768  , CW_GQ = 40960  ;
constexpr int RING_OFF = 0, RING_BYTES = 151552;
constexpr int LDSCTL_OFF = RING_BYTES, MISC_OFF = LDSCTL_OFF + 320;
constexpr int LDS_BYTES = 152576;
static_assert(att::SHM_ATTN <= RING_BYTES && att::GM_END <= RING_BYTES && MISC_OFF + 128 <= LDS_BYTES && LDS_BYTES <= 163840, "LDS map");

struct Frame {
    LAS unsigned char* lds;
    volatile LAS unsigned* MISC;
    gu32* ctl;
    int wave;
    int vcu, G;
};

__device__ __forceinline__ int fresh_tid() { int t = threadIdx.x; asm volatile("" : "+v"(t)); return t; }
__device__ __forceinline__ float wave_sum(float v) {
    v += __int_as_float(__builtin_amdgcn_ds_swizzle(__float_as_int(v), (1 << 10) | 0x1f));
    v += __int_as_float(__builtin_amdgcn_ds_swizzle(__float_as_int(v), (2 << 10) | 0x1f));
    v += __int_as_float(__builtin_amdgcn_ds_swizzle(__float_as_int(v), (4 << 10) | 0x1f));
    v += __int_as_float(__builtin_amdgcn_ds_swizzle(__float_as_int(v), (8 << 10) | 0x1f));
    v += __int_as_float(__builtin_amdgcn_ds_swizzle(__float_as_int(v), (16 << 10) | 0x1f));
    { auto rr = __builtin_amdgcn_permlane32_swap(__float_as_uint(v), __float_as_uint(v), false, false); v = __uint_as_float(rr[0]) + __uint_as_float(rr[1]); }
    return v;
}
__device__ __forceinline__ int dest_row(int n, int mode) {
    if (mode == 1) { if (n >= 2048 && n < 4096) { const int i = n & 63; return (n & ~63) + (i < 32 ? 2 * i : 2 * (i - 32) + 1); }
                     if (n >= 5120) { const int j = (n - 5120) & 2047, hi = (n - 5120) >> 11; return 5120 + (j >> 7) * 256 + hi * 128 + (j & 127); }
                     return n; }
    if (mode == 2) return (n >> 7) * 256 + (n & 127);
    if (mode == 3) return (n >> 7) * 256 + 128 + (n & 127);
    return n;
}
__device__ __forceinline__ void p0_transpose_item(const float* W, int K, int N, bf16* WT, int mode, LAS float* scr, int item, int lane, int ldk = 0, int koff = 0) {
    const int nblk = N / 32, kb = item / nblk, nb = item % nblk, k0 = 64 * kb, n0 = 32 * nb;
#pragma unroll 8
    for (int i = 0; i < 32; ++i) { const int kk = 2 * i + (lane >> 5); scr[kk * 33 + (lane & 31)] = __builtin_nontemporal_load(&W[(size_t)(k0 + kk) * N + n0 + (lane & 31)]); }
    LDS_WAIT(); asm volatile("" ::: "memory");
    const int c = lane & 7;
#pragma unroll
    for (int j = 0; j < 4; ++j) { const int n = (lane >> 3) + 8 * j; const LAS float* s = scr + (8 * c) * 33 + n;
        v4u o; o.x = pk2(s[0 * 33], s[1 * 33]); o.y = pk2(s[2 * 33], s[3 * 33]); o.z = pk2(s[4 * 33], s[5 * 33]); o.w = pk2(s[6 * 33], s[7 * 33]);
        *(GAS v4u*)(WT + (size_t)dest_row(n0 + n, mode) * (ldk ? ldk : K) + koff + k0 + 8 * c) = o; }
    LDS_WAIT(); asm volatile("" ::: "memory");
}

struct In {
    const float *x, *c, *ada_w, *ada_b, *norm1_g, *norm2_g, *w_in, *gmlp_ln_g, *gmlp_ln_b, *w_s, *b_s, *lq1, *lk1, *lq2, *lk2, *subln_g, *w_up_gmlp, *w_up_attn, *w_o, *ffn_w1, *ffn_w3, *ffn_w2, *final_g;
};
struct Args { In in; float* out; unsigned char* ws; };

__device__ __forceinline__ void p0_prologue(const Frame& F, const In& I, unsigned char* ws) {
    const int tid = fresh_tid(), lane = tid & 63;
    float* mod = (float*)(ws + WS_MOD);
    {
        constexpr int SW = 192, NSTRIP = MODW / SW;
        LAS float* cact = (LAS float*)(F.lds + RING_OFF);
        LAS float* red = (LAS float*)(F.lds + RING_OFF + 32768);
        bool have = false;
        for (int it = F.vcu; it < DEPTH * NSTRIP; it += F.G) {
            if (!have) { for (int i = tid; i < NB * DM; i += NWAVES * 64) { const float cv = I.c[i]; cact[i] = cv / (1.0f + expf(-cv)); } have = true; __syncthreads(); }
            const int l = it / NSTRIP, s = it % NSTRIP;
            f32x4 a0 = {0.f, 0.f, 0.f, 0.f}, a1 = a0, a2 = a0, a3 = a0;
            if (lane < SW / 4) {
                const float* wp = I.ada_w + ((size_t)l * DM + F.wave * 256) * MODW + s * SW + 4 * lane;
                const LAS float* cp = cact + F.wave * 256;
#pragma unroll 8
                for (int kk = 0; kk < 256; ++kk) { const f32x4 w = __builtin_nontemporal_load((const f32x4*)(wp + (size_t)kk * MODW));
                    a0 += w * cp[kk]; a1 += w * cp[DM + kk]; a2 += w * cp[2 * DM + kk]; a3 += w * cp[3 * DM + kk]; }
                *(LAS f32x4*)(red + (F.wave * NB + 0) * SW + 4 * lane) = a0; *(LAS f32x4*)(red + (F.wave * NB + 1) * SW + 4 * lane) = a1;
                *(LAS f32x4*)(red + (F.wave * NB + 2) * SW + 4 * lane) = a2; *(LAS f32x4*)(red + (F.wave * NB + 3) * SW + 4 * lane) = a3;
            }
            __syncthreads();
            for (int idx = tid; idx < NB * SW; idx += NWAVES * 64) { const int b = idx / SW, col = idx % SW; float sum = I.ada_b[(size_t)l * MODW + s * SW + col];
#pragma unroll
                for (int w = 0; w < 8; ++w) sum += red[(w * NB + b) * SW + col];
                mod[((size_t)l * NB + b) * MODW + s * SW + col] = sum; }
            __syncthreads();
        }
        __syncthreads();
    }
    const int gtid = F.vcu * (NWAVES * 64) + tid, NGT = F.G * NWAVES * 64;
    {
        float* rc = (float*)(ws + WS_ROPE); float* rs = rc + SEQ * 32;
        for (int idx = gtid; idx < SEQ * 32; idx += NGT) { const int pos = idx >> 5, i = idx & 31;
            const float invf = (float)exp2(-(double)i * (13.287712379549449 / 32.0));
            const float angf = (float)pos * invf; const double ang = (double)angf;
            const double kq = rint(ang * 0.63661977236758134); const double t = (ang - kq * 1.5707963267948966) - kq * 6.123233995736766e-17; const double t2 = t * t;
            const double sp = t * (1.0 + t2 * (-1.0 / 6 + t2 * (1.0 / 120 + t2 * (-1.0 / 5040 + t2 * (1.0 / 362880 + t2 * (-1.0 / 39916800))))));
            const double cp = 1.0 + t2 * (-0.5 + t2 * (1.0 / 24 + t2 * (-1.0 / 720 + t2 * (1.0 / 40320 + t2 * (-1.0 / 3628800 + t2 * (1.0 / 479001600))))));
            const int qd = ((int)kq) & 3; const double cv = qd == 0 ? cp : qd == 1 ? -sp : qd == 2 ? -cp : sp; const double sv = qd == 0 ? sp : qd == 1 ? cp : qd == 2 ? -sp : -cp;
            rc[idx] = (float)cv; rs[idx] = (float)sv; }
    }
    if (blockIdx.x == 0 && F.wave == 0) {
        for (int l = 0; l < DEPTH; ++l) { const float s1 = wave_sum(I.lq1[l * 64 + lane] * I.lk1[l * 64 + lane]), s2 = wave_sum(I.lq2[l * 64 + lane] * I.lk2[l * 64 + lane]);
            const float linit = 0.8f - 0.6f * expf(-0.3f * (float)l);
            if (lane == 0) ((float*)(ws + WS_LAM))[l] = expf(s1) - expf(s2) + linit; }
    }
    { bf16* wsb = (bf16*)(ws + WS_WSB);
        for (int i = gtid; i < DEPTH * 8 * 128 * 128 / 4; i += NGT) { const f32x4 v = *(const f32x4*)(I.w_s + (size_t)i * 4); unsigned long long o = (unsigned long long)pk2(v.x, v.y) | ((unsigned long long)pk2(v.z, v.w) << 32); *(GAS unsigned long long*)(wsb + (size_t)i * 4) = o; } }
    LAS float* scr = (LAS float*)(F.lds + RING_OFF + F.wave * 16384);
    const int gw = F.vcu * NWAVES + F.wave, NGW = F.G * NWAVES;
    constexpr int I_IN = (DM / 64) * (DIN / 32), I_UP = (1024 / 64) * (DM / 32), I_O = (DM / 64) * (DM / 32), I_F1 = (DM / 64) * (FFH / 32), I_F2 = (FFH / 64) * (DM / 32);
    constexpr int I_LAYER = I_IN + 2 * I_UP + I_O + 2 * I_F1 + I_F2;
    for (int it = gw; it < DEPTH * I_LAYER; it += NGW) {
        const int l = it / I_LAYER; int r = it % I_LAYER;
        if (r < I_IN) { p0_transpose_item(I.w_in + (size_t)l * DM * DIN, DM, DIN, (bf16*)(ws + WS_WIN) + (size_t)l * DIN * DM, 1, scr, r, lane); continue; } r -= I_IN;
        if (r < I_UP) { p0_transpose_item(I.w_up_gmlp + (size_t)l * 1024 * DM, 1024, DM, (bf16*)(ws + WS_WUG) + (size_t)l * DM * DM, 0, scr, r, lane, DM, 0); continue; } r -= I_UP;
        if (r < I_UP) { p0_transpose_item(I.w_up_attn + (size_t)l * 1024 * DM, 1024, DM, (bf16*)(ws + WS_WUG) + (size_t)l * DM * DM, 0, scr, r, lane, DM, 1024); continue; } r -= I_UP;
        if (r < I_O) { p0_transpose_item(I.w_o + (size_t)l * DM * DM, DM, DM, (bf16*)(ws + WS_WO) + (size_t)l * DM * DM, 0, scr, r, lane); continue; } r -= I_O;
        if (r < I_F1) { p0_transpose_item(I.ffn_w1 + (size_t)l * DM * FFH, DM, FFH, (bf16*)(ws + WS_W13) + (size_t)l * NF13 * DM, 2, scr, r, lane); continue; } r -= I_F1;
        if (r < I_F1) { p0_transpose_item(I.ffn_w3 + (size_t)l * DM * FFH, DM, FFH, (bf16*)(ws + WS_W13) + (size_t)l * NF13 * DM, 3, scr, r, lane); continue; } r -= I_F1;
        p0_transpose_item(I.ffn_w2 + (size_t)l * FFH * DM, FFH, DM, (bf16*)(ws + WS_W2) + (size_t)l * DM * FFH, 0, scr, r, lane);
    }
}

__device__ __forceinline__ void add_bf16x4(f32x4& v, unsigned long long d) { const unsigned lo = (unsigned)d, hi = (unsigned)(d >> 32);
    v.x += __uint_as_float(lo << 16); v.y += __uint_as_float(lo & 0xffff0000u); v.z += __uint_as_float(hi << 16); v.w += __uint_as_float(hi & 0xffff0000u); }
__device__ __forceinline__ void norm_mod_phase(const Frame& F0, const float* xin, const bf16* d1, const bf16* d2, float* xout, const float* g, const float* sh, const float* sc, bf16* H) {
    const Frame& F = F0; const int lane = fresh_tid() & 63;
    int wv_ = F.wave; asm volatile("" : "+s"(wv_));
    int vr_ = F.vcu; if (F.G == NCU_NOM) vr_ = (vr_ & ~31) + (vr_ & 7) * 4 + ((vr_ & 31) >> 3);
    const int gw = vr_ * NWAVES + wv_, NGW = F.G * NWAVES;
    for (int r0 = gw * 8; r0 < MTOK; r0 += NGW * 8) {
        const int b = r0 / SEQ; const float* shb = sh + (size_t)b * MODW + 4 * lane; const float* scb = sc + (size_t)b * MODW + 4 * lane;
        f32x4 cf[8], sv[8];
#pragma unroll
        for (int j = 0; j < 8; ++j) { const f32x4 g4 = *(const f32x4*)(g + 256 * j + 4 * lane), s4 = *(const f32x4*)(scb + 256 * j); cf[j] = g4 * (1.0f + s4); sv[j] = *(const f32x4*)(shb + 256 * j); }
#pragma unroll 2
        for (int i = 0; i < 8; ++i) {
            const GAS f32x4* xr = (const GAS f32x4*)(xin + (size_t)(r0 + i) * DM) + lane;
            f32x4 v[8]; float ss = 0.f;
#pragma unroll
            for (int j = 0; j < 8; ++j) v[j] = __builtin_nontemporal_load(&xr[64 * j]);
            if (d1) { const GAS unsigned long long* dr = (const GAS unsigned long long*)(d1 + (size_t)(r0 + i) * DM) + lane;
#pragma unroll
                for (int j = 0; j < 8; ++j) add_bf16x4(v[j], __builtin_nontemporal_load(&dr[64 * j])); }
            if (d2) { const GAS unsigned long long* dr = (const GAS unsigned long long*)(d2 + (size_t)(r0 + i) * DM) + lane;
#pragma unroll
                for (int j = 0; j < 8; ++j) add_bf16x4(v[j], __builtin_nontemporal_load(&dr[64 * j])); }
            if (xout) { GAS f32x4* xw = (GAS f32x4*)(xout + (size_t)(r0 + i) * DM) + lane;
#pragma unroll
                for (int j = 0; j < 8; ++j) __builtin_nontemporal_store(v[j], &xw[64 * j]); }
#pragma unroll
            for (int j = 0; j < 8; ++j) ss += (v[j].x * v[j].x + v[j].y * v[j].y) + (v[j].z * v[j].z + v[j].w * v[j].w);
            const float r = 1.0f / sqrtf(wave_sum(ss) * (1.0f / DM) + EPS);
            GAS unsigned long long* o8 = (GAS unsigned long long*)(H + (size_t)(r0 + i) * DM) + lane;
#pragma unroll
            for (int j = 0; j < 8; ++j) { const f32x4 y = v[j] * r * cf[j] + sv[j]; o8[64 * j] = (unsigned long long)pk2(y.x, y.y) | ((unsigned long long)pk2(y.z, y.w) << 32); }
        }
    }
}
__device__ __forceinline__ void final_norm_phase(const Frame& F, const float* x, const bf16* d1, const bf16* d2, const float* g, float* out, bool poison) {
    const int lane = fresh_tid() & 63;
    const int gw = F.vcu * NWAVES + F.wave, NGW = F.G * NWAVES; const float qn = __builtin_nanf("");
    f32x4 gv[8];
#pragma unroll
    for (int j = 0; j < 8; ++j) gv[j] = *(const f32x4*)(g + 256 * j + 4 * lane);
    for (int row = gw; row < MTOK; row += NGW) {
        const GAS f32x4* xr = (const GAS f32x4*)(x + (size_t)row * DM) + lane;
        const GAS unsigned long long* dr1 = (const GAS unsigned long long*)(d1 + (size_t)row * DM) + lane; const GAS unsigned long long* dr2 = (const GAS unsigned long long*)(d2 + (size_t)row * DM) + lane;
        f32x4 v[8]; float ss = 0.f;
#pragma unroll
        for (int j = 0; j < 8; ++j) { v[j] = __builtin_nontemporal_load(&xr[64 * j]); add_bf16x4(v[j], __builtin_nontemporal_load(&dr1[64 * j])); add_bf16x4(v[j], __builtin_nontemporal_load(&dr2[64 * j]));
            ss += (v[j].x * v[j].x + v[j].y * v[j].y) + (v[j].z * v[j].z + v[j].w * v[j].w); }
        const float r = 1.0f / sqrtf(wave_sum(ss) * (1.0f / DM) + EPS);
        GAS f32x4* o = (GAS f32x4*)(out + (size_t)row * DM) + lane;
#pragma unroll
        for (int j = 0; j < 8; ++j) { f32x4 y = v[j] * r * gv[j]; if (poison) y = (f32x4){qn, qn, qn, qn}; __builtin_nontemporal_store(y, &o[64 * j]); }
    }
}

#ifndef ATT_FN
#define ATT_FN attn_unit_d
#endif
#ifndef THIN_ALIGN
#define THIN_ALIGN true
#endif
__global__ void __launch_bounds__(NWAVES * 64, 2) mk_fwd(Args args) {
    extern __shared__ __attribute__((aligned(16))) unsigned char lds[];
    Frame F;
    F.lds = (LAS unsigned char*)lds;
    F.MISC = (volatile LAS unsigned*)(F.lds + MISC_OFF);
    F.wave = __builtin_amdgcn_readfirstlane(threadIdx.x >> 6);
    F.G = gridDim.x; { const int bx = blockIdx.x; F.vcu = (F.G % 8 == 0) ? (bx % 8) * (F.G / 8) + bx / 8 : bx; }
    unsigned char* ws = args.ws; const In& I = args.in;
    F.ctl = (gu32*)(ws + WS_CTL);
    for (int u = threadIdx.x; u < (LDS_BYTES - LDSCTL_OFF) / 4; u += NWAVES * 64) ((LAS unsigned*)(F.lds + LDSCTL_OFF))[u] = 0u;
    __syncthreads();
    XcdBarrier bar = xcd_barrier_post((unsigned*)(F.ctl + CW_BAR), F.MISC + 8);
#ifdef PROBE_MASK
    if (blockIdx.x == 0 && threadIdx.x == 0) ((LAS unsigned*)(F.lds + LDSCTL_OFF))[30] = (unsigned)rt();
#ifdef PROBE_CYC
    if (blockIdx.x == 0 && threadIdx.x == 0) ((LAS unsigned*)(F.lds + LDSCTL_OFF))[30] = (unsigned)__builtin_readcyclecounter();
#define STAMP(p) do { if (blockIdx.x == 0 && threadIdx.x == 0) { LAS unsigned* w_ = (LAS unsigned*)(F.lds + LDSCTL_OFF); const unsigned t_ = (unsigned)__builtin_readcyclecounter(); w_[p] += (t_ - w_[30]) / 24u; w_[30] = t_; } } while (0)
#else
#define STAMP(p) do { if (blockIdx.x == 0 && threadIdx.x == 0) { LAS unsigned* w_ = (LAS unsigned*)(F.lds + LDSCTL_OFF); const unsigned t_ = (unsigned)rt(); w_[p] += t_ - w_[30]; w_[30] = t_; } } while (0)
#endif
#else
#define STAMP(p) do { } while (0)
#endif
#define BAR_DO_(LOC) do { XcdBarrier b2_ = bar; asm volatile("" : "+s"(b2_.bar), "+s"(b2_.x)); \
    if ((LOC) && (unsigned)__builtin_amdgcn_readfirstlane((int)F.MISC[10]) == 2u) quad_barrier(b2_); else xcd_barrier(b2_); } while (0)
#ifdef PROBE_BWAIT
#define BAR_T_(LOC) do { unsigned long long tb_ = 0; if (blockIdx.x == PROBE_BLK && threadIdx.x == 0) tb_ = rt(); BAR_DO_(LOC); \
    if (blockIdx.x == PROBE_BLK && threadIdx.x == 0) { LAS unsigned* w_ = (LAS unsigned*)(F.lds + LDSCTL_OFF); const unsigned k_ = w_[27]; w_[27] = k_ + 1; const unsigned ty_ = k_ == 0 ? 0u : 1u + (k_ - 1u) % 8u; \
        if ((PROBE_BMASK >> ty_) & 1) w_[28] += (unsigned)(rt() - tb_); } } while (0)
#define GRID_BAR() BAR_T_(0)
#define LOCAL_BAR() BAR_T_(1)
#else
#define GRID_BAR() BAR_DO_(0)
#define LOCAL_BAR() BAR_DO_(1)
#endif

    float* const mod = (float*)(ws + WS_MOD);
    const float* const rcos = (const float*)(ws + WS_ROPE); const float* const rsin = rcos + SEQ * 32;
    float* const X = (float*)(ws + WS_X);
    bf16* const H = (bf16*)(ws + WS_H); bf16* const BRA = (bf16*)(ws + WS_BRA); bf16* const BRB = (bf16*)(ws + WS_BRA) + 1024;   bf16* const MG = (bf16*)(ws + WS_MG);
    bf16* const D1 = (bf16*)(ws + WS_D); bf16* const D2 = D1 + (size_t)MTOK * DM;
    bf16* const P = (bf16*)(ws + WS_P); bf16* const T = (bf16*)(ws + WS_T);
    pg8::f32x2* const vstat = (pg8::f32x2*)(ws + WS_VSTAT);

#ifndef PHM
#define PHM 0xFFFFF
#endif
#ifdef PROBE_IDLE
    { if (threadIdx.x == 0) { const unsigned long long t0_ = rt(); while (rt() - t0_ < (unsigned long long)PROBE_IDLE) __builtin_amdgcn_s_sleep(32); } __syncthreads(); }
#endif
    if constexpr (PHM & 1) p0_prologue(F, I, ws);
    GRID_BAR();
    if (threadIdx.x == 0) F.MISC[10] = (xb_ld((unsigned*)(F.ctl + CW_BAR) + XB_NONLOC) == 0u) ? 2u : 1u;
    __syncthreads();
    STAMP(0);

    for (int l = 0; l < DEPTH; ++l) {
        const float* modl = mod + (size_t)l * NB * MODW;
        const float* xin = (l == 0) ? I.x : X;
        const float* xprev = (l <= 1) ? I.x : X;
        if constexpr (PHM & 2) norm_mod_phase(F, (l == 0) ? xin : xprev, (l == 0) ? (const bf16*)nullptr : (const bf16*)D1, (l == 0) ? (const bf16*)nullptr : (const bf16*)D2, (l == 0) ? (float*)nullptr : X, I.norm1_g + (size_t)l * DM, modl + 0 * DM, modl + 1 * DM, H);
        LOCAL_BAR();
        STAMP(1);
        if constexpr (PHM & 4) { pg8::Gemm g{H, (const bf16*)(ws + WS_WIN) + (size_t)l * DIN * DM, MTOK, DIN, DM}; pg8::UvOrder S; S.init(MTOK, DIN, F.G, (int)blockIdx.x); S.cnt = (unsigned*)(F.ctl + CW_UV);
          pg8::EpiIn E{P, (bf16*)(ws + WS_QKV), rcos, rsin, vstat};
          pg8::gemm_phase<pg8::EpiIn, pg8::UvOrder, true, true>(F.lds + RING_OFF, g, S, E); }
        if constexpr (PHM & 0x2000) {
            volatile LAS unsigned* const gqw = (volatile LAS unsigned*)(F.lds + LDSCTL_OFF) + 24;
            unsigned* const gq = (unsigned*)(F.ctl + CW_GQ) + 64 * l; unsigned* const uvc = (unsigned*)(F.ctl + CW_UV); const unsigned need = 512u * (unsigned)(l + 1);
            int t0_ = threadIdx.x; asm volatile("" : "+v"(t0_));
            __syncthreads();
            if (t0_ == 0) { const unsigned first = xb_add(gq, 1u);
                unsigned ok = 1u;
                for (int gi = 0; gi < MTOK / 2048; ++gi) ok &= (xb_ld(uvc + 64 * gi) >= need) ? 1u : 0u;
                if (!ok) for (int gi = 0; gi < MTOK / 2048; ++gi) XB_SPIN(xb_ld(uvc + 64 * gi) < need, (unsigned*)(F.ctl + CW_BAR));
                __builtin_amdgcn_fence(__ATOMIC_ACQUIRE, "agent"); asm volatile("s_waitcnt vmcnt(0)" ::: "memory");
                gqw[0] = first; }
            __syncthreads();
            { const int gu0 = __builtin_amdgcn_readfirstlane((int)gqw[0]);
              __syncthreads();
              att::gmlp_units<true>(P, BRA, (const att::f32x2v*)vstat, (const bf16*)(ws + WS_WSB) + (size_t)l * 8 * 128 * 128, I.b_s + (size_t)l * 8 * 128, I.gmlp_ln_g + (size_t)l * 1024, I.gmlp_ln_b + (size_t)l * 1024,
                                     gu0, 0, NB * (SEQ / 128) * 8, (LAS char*)(F.lds + RING_OFF), gq, gqw); }
            __syncthreads();
        }
        GRID_BAR();
        STAMP(2);
        if constexpr (PHM & 8) { const float lam = __uint_as_float((unsigned)__builtin_amdgcn_readfirstlane((int)__float_as_uint(((const float*)(ws + WS_LAM))[l]))); const float oml = __uint_as_float((unsigned)__builtin_amdgcn_readfirstlane((int)__float_as_uint(1.0f - (0.8f - 0.6f * expf(-0.3f * (float)l)))));
          const bf16* const qkv = (const bf16*)(ws + WS_QKV); const float* const sg = I.subln_g + (size_t)l * 128;
          unsigned redo = 0u; int ui = 0;
          int vc_ = F.vcu; asm volatile("" : "+s"(vc_));
          if constexpr (PHM & 0x1000) for (int u = vc_; u < NB * 8 * (SEQ / 128); u += F.G, ++ui) { const int bh = u >> 5, qb = u & 31;
              if (att::ATT_FN<true>(qkv, BRB, bh >> 3, bh & 7, qb, lam, oml, sg, (LAS char*)(F.lds + RING_OFF))) redo |= 1u << (ui & 31); __syncthreads(); }
          if (redo != 0u) { ui = 0;
              for (int u = F.vcu; u < NB * 8 * (SEQ / 128); u += F.G, ++ui) if ((redo >> (ui & 31)) & 1u) { const int bh = u >> 5, qb = u & 31;
                  (void)att::ATT_FN<false>(qkv, BRB, bh >> 3, bh & 7, qb, lam, oml, sg, (LAS char*)(F.lds + RING_OFF)); __syncthreads(); } }
          STAMP(3); }
        GRID_BAR();
        STAMP(10);
        if constexpr (PHM & 16) { pg8::Gemm g{BRA, (const bf16*)(ws + WS_WUG) + (size_t)l * DM * DM, MTOK, DM, DM}; pg8::StaticOrder S; S.init(MTOK, DM, F.G, (int)blockIdx.x);
          pg8::EpiUpCat E{MG, P, PC_G0, PC_G1};
          pg8::gemm_phase<pg8::EpiUpCat, pg8::StaticOrder, THIN_ALIGN, true>(F.lds + RING_OFF, g, S, E); }
        LOCAL_BAR();
        STAMP(4);
        if constexpr (PHM & 64) { pg8::Gemm g{MG, (const bf16*)(ws + WS_WO) + (size_t)l * DM * DM, MTOK, DM, DM}; pg8::StaticOrder S; S.init(MTOK, DM, F.G, (int)blockIdx.x);
          pg8::EpiDelta E{D1, modl + 2 * DM, MODW};
          pg8::gemm_phase<pg8::EpiDelta, pg8::StaticOrder, THIN_ALIGN, true>(F.lds + RING_OFF, g, S, E); }
        LOCAL_BAR();
        STAMP(5);
        if constexpr (PHM & 128) norm_mod_phase(F, xin, D1, (const bf16*)nullptr, (float*)nullptr, I.norm2_g + (size_t)l * DM, modl + 3 * DM, modl + 4 * DM, H);
        LOCAL_BAR();
        STAMP(6);
        if constexpr (PHM & 256) { pg8::Gemm g{H, (const bf16*)(ws + WS_W13) + (size_t)l * NF13 * DM, MTOK, NF13, DM}; pg8::StaticOrder S; S.init(MTOK, NF13, F.G, (int)blockIdx.x);
          pg8::EpiSwiglu E{T};
          pg8::gemm_phase<pg8::EpiSwiglu, pg8::StaticOrder, true, true>(F.lds + RING_OFF, g, S, E); }
        LOCAL_BAR();
        STAMP(7);
        if constexpr (PHM & 512) { pg8::Gemm g{T, (const bf16*)(ws + WS_W2) + (size_t)l * DM * FFH, MTOK, DM, FFH}; pg8::StaticOrder S; S.init(MTOK, DM, F.G, (int)blockIdx.x);
          pg8::EpiDelta E{D2, modl + 5 * DM, MODW};
          pg8::gemm_phase<pg8::EpiDelta, pg8::StaticOrder, THIN_ALIGN, true>(F.lds + RING_OFF, g, S, E); }
        if (l == DEPTH - 1) GRID_BAR(); else LOCAL_BAR();
        STAMP(8);
    }
    { const bool poison = (__hip_atomic_load((gu32*)((unsigned*)(F.ctl + CW_BAR) + XB_TMO), RLX_AGENT) != 0u) || (__hip_atomic_load(F.ctl + CW_TMO, RLX_AGENT) != 0u);
      final_norm_phase(F, (DEPTH <= 1) ? I.x : X, D1, D2, I.final_g, args.out, poison); }
#ifdef PROBE_BWAIT
    if (blockIdx.x == PROBE_BLK && threadIdx.x == 0) { unsigned long long tot = ((LAS unsigned*)(F.lds + LDSCTL_OFF))[28]; tot *= PROBE_MUL; const unsigned long long t0 = rt(); while (rt() - t0 < tot) __builtin_amdgcn_s_sleep(16); }
#endif
#ifdef PROBE_MASK
    STAMP(9);
    if (blockIdx.x == 0 && threadIdx.x == 0) { unsigned long long tot = 0; for (int p = 0; p < 16; ++p) if ((PROBE_MASK >> p) & 1) tot += ((LAS unsigned*)(F.lds + LDSCTL_OFF))[p];
        tot *= PROBE_MUL; const unsigned long long t0 = rt(); while (rt() - t0 < tot) __builtin_amdgcn_s_sleep(16); }
#endif
#undef GRID_BAR
}

extern "C" void kernel_launch(void* const* d_in, const int* in_sizes, int n_in, void* d_out, int out_size, void* d_ws, size_t ws_size, hipStream_t stream) {
    static int grid = 0;
    if (grid == 0) {
        if (n_in != 23 || in_sizes[0] != MTOK * DM || out_size != MTOK * DM || ws_size < WS_END) { fprintf(stderr, "kernel_launch: unexpected shapes: n_in %d in0 %d out %d ws %zu (need %zu)\n", n_in, n_in > 0 ? in_sizes[0] : -1, out_size, ws_size, (size_t)WS_END); grid = -1; return; }
        int dev = 0, cus = 0, per_cu = 0;
        if (hipGetDevice(&dev) != hipSuccess || hipDeviceGetAttribute(&cus, hipDeviceAttributeMultiprocessorCount, dev) != hipSuccess) { fprintf(stderr, "kernel_launch: device query failed\n"); grid = -1; return; }
        if (hipFuncSetAttribute((const void*)mk_fwd, hipFuncAttributeMaxDynamicSharedMemorySize, LDS_BYTES) != hipSuccess) { fprintf(stderr, "kernel_launch: hipFuncSetAttribute failed\n"); grid = -1; return; }
        if (hipOccupancyMaxActiveBlocksPerMultiprocessor(&per_cu, (const void*)mk_fwd, NWAVES * 64, LDS_BYTES) != hipSuccess || per_cu < 1) { fprintf(stderr, "kernel_launch: occupancy query reports %d blocks per CU\n", per_cu); }
        (void)hipGetLastError();
        grid = cus;
    }
    if (grid < 0) return;
    if (hipMemsetAsync((char*)d_ws + WS_CTL, 0, CTL_ZERO_BYTES, stream) != hipSuccess) { fprintf(stderr, "kernel_launch: memset failed\n"); return; }
    Args a{};
    const float** ip = (const float**)&a.in;
    for (int i = 0; i < 23; ++i) ip[i] = (const float*)d_in[i];
    a.out = (float*)d_out; a.ws = (unsigned char*)d_ws;
    hipLaunchKernelGGL(mk_fwd, dim3(grid), dim3(NWAVES * 64), LDS_BYTES, stream, a);
    const hipError_t le = hipPeekAtLastError();
    if (le != hipSuccess) fprintf(stderr, "kernel_launch: launch failed: %s\n", hipGetErrorName(le));
}
```
